# Optimizing an MI355X kernel written in HIP

```python
import jax, jax.numpy as jnp
from jax import lax
import numpy as np

D_MODEL = 2048
BATCH = 4
SEQ = 4096
DEPTH = 4

N_EVEN = (DEPTH + 1) // 2
N_ODD = DEPTH // 2
HEAD_DIM = 128
H_HGRN = D_MODEL // 2 // HEAD_DIM
H_RET = D_MODEL // 2 // HEAD_DIM
D_HGRN = H_HGRN * HEAD_DIM
D_RET = H_RET * HEAD_DIM
H_FOX = D_MODEL // HEAD_DIM
D_FOX = H_FOX * HEAD_DIM
EVEN_IN = 4 * D_HGRN + 4 * D_RET
ODD_IN = 4 * D_FOX + H_FOX
D_FF = 128 * ((8 * D_MODEL // 3 + 127) // 128)
CONV_WIDTH = 3
CHUNK = 64
Q_BLOCK = 128
ROPE_BASE = 10000.0
RET_DECAY_BASE = 5.0
FOX_FORGET_BIAS = 3.0
EPS = 1e-6
LB_FLOOR = 1e-30
MASK_VALUE = -1e30

kernel_name = 'hybrid_hgrn2_retnet_fox_convffn'


def rmsnorm(x, w):
    xf = x.astype(jnp.float32)
    y = xf * lax.rsqrt(jnp.mean(xf * xf, axis=-1, keepdims=True) + EPS)
    return (y * w.astype(jnp.float32)).astype(x.dtype)


def head_rmsnorm(o, w):
    y = o * lax.rsqrt(jnp.mean(o * o, axis=-1, keepdims=True) + EPS)
    return y * w.astype(jnp.float32).reshape(o.shape[2:])


def head_layernorm(o, w):
    mu = jnp.mean(o, axis=-1, keepdims=True)
    c = o - mu
    y = c * lax.rsqrt(jnp.mean(c * c, axis=-1, keepdims=True) + EPS)
    return y * w.astype(jnp.float32).reshape(o.shape[2:])


def rotary(x, positions):
    d = x.shape[-1]
    inv = ROPE_BASE ** (-jnp.arange(0, d, 2, dtype=jnp.float32) / d)
    ang = positions.astype(jnp.float32)[:, None] * inv[None, :]
    cos = jnp.cos(ang)[None, :, None, :]
    sin = jnp.sin(ang)[None, :, None, :]
    x1, x2 = x[..., : d // 2], x[..., d // 2:]
    return jnp.concatenate([x1 * cos - x2 * sin, x2 * cos + x1 * sin], axis=-1)


def hgrn2_chunkwise(q, k, v, log_f):
    B, S, H, dk = q.shape
    dv = v.shape[-1]
    n = S // CHUNK

    def to_chunks(t):
        return t.reshape(B, n, CHUNK, H, t.shape[-1]).transpose(1, 0, 3, 2, 4)

    causal = jnp.tril(jnp.ones((CHUNK, CHUNK), dtype=bool))[None, None, :, :, None]

    def step(state, xs):
        qc, kc, vc, gc = xs
        b = jnp.cumsum(gc, axis=2)
        diff = b[:, :, :, None, :] - b[:, :, None, :, :]
        decay = jnp.where(causal, jnp.exp(jnp.minimum(diff, 0.0)), 0.0)
        scores = jnp.einsum('bhtd,bhsd,bhtsd->bhts', qc, kc, decay)
        o = (jnp.einsum('bhts,bhsv->bhtv', scores, vc)
             + jnp.einsum('bhtd,bhdv->bhtv', qc * jnp.exp(b), state))
        b_last = b[:, :, -1:, :]
        state = (jnp.exp(b_last)[:, :, 0, :, None] * state
                 + jnp.einsum('bhsd,bhsv->bhdv', kc * jnp.exp(b_last - b), vc))
        return state, o

    state0 = jnp.zeros((B, H, dk, dv), q.dtype)
    _, o = lax.scan(step, state0, (to_chunks(q), to_chunks(k), to_chunks(v), to_chunks(log_f)))
    return o.transpose(1, 0, 3, 2, 4).reshape(B, S, H, dv)


def retention_chunkwise(q, k, v, log_gamma):
    B, S, H, dk = q.shape
    dv = v.shape[-1]
    n = S // CHUNK

    def to_chunks(t):
        return t.reshape(B, n, CHUNK, H, t.shape[-1]).transpose(0, 3, 1, 2, 4)

    qc, kc, vc = to_chunks(q), to_chunks(k), to_chunks(v)
    pos = jnp.arange(CHUNK, dtype=jnp.float32)
    rel = pos[:, None] - pos[None, :]
    intra = jnp.where(rel >= 0, jnp.exp(log_gamma[:, None, None] * jnp.maximum(rel, 0.0)), 0.0)
    scores = jnp.einsum('bhntd,bhnsd->bhnts', qc, kc) * intra[None, :, None]
    o = jnp.einsum('bhnts,bhnsv->bhntv', scores, vc)
    w_end = jnp.exp(log_gamma[:, None] * (CHUNK - 1 - pos)[None, :])
    kv = jnp.einsum('bhnsd,hs,bhnsv->nbhdv', kc, w_end, vc)
    decay_chunk = jnp.exp(log_gamma * CHUNK)[None, :, None, None]

    def step(state, kv_n):
        return decay_chunk * state + kv_n, state

    _, prev = lax.scan(step, jnp.zeros_like(kv[0]), kv)
    w_start = jnp.exp(log_gamma[:, None] * (pos + 1.0)[None, :])
    o = o + jnp.einsum('bhntd,ht,nbhdv->bhntv', qc, w_start, prev)
    return o.transpose(0, 2, 3, 1, 4).reshape(B, S, H, dv)


def even_mixer(h, w_in, lb, hgrn_norm_w, ret_norm_w, w_out, positions):
    B, S, _ = h.shape
    f32 = jnp.float32
    proj = h @ w_in
    cuts = [D_HGRN, 2 * D_HGRN, 3 * D_HGRN, 4 * D_HGRN,
            4 * D_HGRN + D_RET, 4 * D_HGRN + 2 * D_RET, 4 * D_HGRN + 3 * D_RET]
    a_q, a_f, a_i, a_g, r_q, r_k, r_v, r_g = jnp.split(proj, cuts, axis=-1)

    def heads(t, n_heads):
        return t.reshape(B, S, n_heads, HEAD_DIM).astype(f32)

    z = heads(a_f, H_HGRN)
    lbh = lb.reshape(H_HGRN, HEAD_DIM).astype(f32)
    log_lb = jnp.log(jnp.maximum(lbh, LB_FLOOR))
    log_f = jnp.logaddexp(log_lb, jnp.log1p(-lbh) + jax.nn.log_sigmoid(z))
    k_in = (1.0 - lbh) * jax.nn.sigmoid(-z)
    o_a = hgrn2_chunkwise(jax.nn.silu(heads(a_q, H_HGRN)), k_in, heads(a_i, H_HGRN), log_f)
    o_a = head_rmsnorm(o_a, hgrn_norm_w).reshape(B, S, D_HGRN) * jax.nn.silu(a_g.astype(f32))

    log_gamma = jnp.log1p(-jnp.exp2(-RET_DECAY_BASE - jnp.arange(H_RET, dtype=f32)))
    rq = rotary(heads(r_q, H_RET), positions)
    rk = rotary(heads(r_k, H_RET), positions) * (HEAD_DIM ** -0.5)
    o_b = retention_chunkwise(rq, rk, heads(r_v, H_RET), log_gamma)
    o_b = head_layernorm(o_b, ret_norm_w).reshape(B, S, D_RET) * jax.nn.silu(r_g.astype(f32))

    o = jnp.concatenate([o_a, o_b], axis=-1).astype(h.dtype)
    return o @ w_out


def fox_attention(q, k, v, c):
    S = q.shape[2]
    outs = []
    for i in range(S // Q_BLOCK):
        t0, t1 = i * Q_BLOCK, (i + 1) * Q_BLOCK
        logits = jnp.einsum('bhtd,bhsd->bhts', q[:, :, t0:t1], k[:, :, :t1],
                            preferred_element_type=jnp.float32)
        logits = logits + c[:, :, t0:t1, None] - c[:, :, None, :t1]
        mask = (t0 + jnp.arange(Q_BLOCK))[:, None] >= jnp.arange(t1)[None, :]
        p = jax.nn.softmax(jnp.where(mask, logits, MASK_VALUE), axis=-1)
        outs.append(jnp.einsum('bhts,bhsv->bhtv', p.astype(v.dtype), v[:, :, :t1]))
    return jnp.concatenate(outs, axis=2)


def fox_mixer(h, w_in, b_f, w_out):
    B, S, _ = h.shape
    proj = h @ w_in
    q, k, v, g, f = jnp.split(proj, [D_FOX, 2 * D_FOX, 3 * D_FOX, 4 * D_FOX], axis=-1)
    log_f = jax.nn.log_sigmoid((f + b_f).astype(jnp.float32))
    c = jnp.cumsum(log_f, axis=1).transpose(0, 2, 1)

    def heads(t):
        return t.reshape(B, S, H_FOX, HEAD_DIM).transpose(0, 2, 1, 3)

    o = fox_attention(heads(q) * (HEAD_DIM ** -0.5), heads(k), heads(v), c)
    o = o.transpose(0, 2, 1, 3).reshape(B, S, D_FOX) * jax.nn.sigmoid(g)
    return o @ w_out


def conv_ffn(h, w_up, conv_w, w_down):
    S = h.shape[1]
    u = h @ w_up
    up = jnp.pad(u, ((0, 0), (CONV_WIDTH - 1, 0), (0, 0)))
    uc = sum(conv_w[j] * up[:, j:j + S] for j in range(CONV_WIDTH))
    gate, val = jnp.split(uc, 2, axis=-1)
    return (jax.nn.silu(gate) * val) @ w_down


def setup_inputs(seed: int = 0) -> dict:
    key = jax.random.key(seed)
    ks = jax.random.split(key, 15)
    f32 = jnp.float32

    def nrm(k, shape, scale):
        return jax.random.normal(k, shape, f32) * scale

    x = nrm(ks[0], (BATCH, SEQ, D_MODEL), 1.0)
    attn_norm_w = 1.0 + nrm(ks[1], (DEPTH, D_MODEL), 0.02)
    ffn_norm_w = 1.0 + nrm(ks[2], (DEPTH, D_MODEL), 0.02)
    final_norm_w = 1.0 + nrm(ks[3], (D_MODEL,), 0.02)
    even_w_in = nrm(ks[4], (N_EVEN, D_MODEL, EVEN_IN), D_MODEL ** -0.5)
    hgrn_lb_logits = nrm(ks[5], (N_EVEN, D_HGRN), 0.5)
    hgrn_norm_w = 1.0 + nrm(ks[6], (N_EVEN, D_HGRN), 0.02)
    ret_norm_w = 1.0 + nrm(ks[7], (N_EVEN, D_RET), 0.02)
    even_w_out = nrm(ks[8], (N_EVEN, D_HGRN + D_RET, D_MODEL), (D_HGRN + D_RET) ** -0.5)
    odd_w_in = nrm(ks[9], (N_ODD, D_MODEL, ODD_IN), D_MODEL ** -0.5)
    odd_b_f = FOX_FORGET_BIAS + nrm(ks[10], (N_ODD, H_FOX), 0.5)
    odd_w_out = nrm(ks[11], (N_ODD, D_FOX, D_MODEL), D_FOX ** -0.5)
    ffn_w_up = nrm(ks[12], (DEPTH, D_MODEL, 2 * D_FF), D_MODEL ** -0.5)
    conv_center = jnp.zeros((CONV_WIDTH, 2 * D_FF), f32).at[CONV_WIDTH - 1].set(1.0)
    ffn_conv_w = conv_center[None] + nrm(ks[13], (DEPTH, CONV_WIDTH, 2 * D_FF), 0.2)
    ffn_w_down = nrm(ks[14], (DEPTH, D_FF, D_MODEL), D_FF ** -0.5)
    return {'x': x, 'attn_norm_w': attn_norm_w, 'ffn_norm_w': ffn_norm_w,
            'final_norm_w': final_norm_w, 'even_w_in': even_w_in,
            'hgrn_lb_logits': hgrn_lb_logits, 'hgrn_norm_w': hgrn_norm_w,
            'ret_norm_w': ret_norm_w, 'even_w_out': even_w_out, 'odd_w_in': odd_w_in,
            'odd_b_f': odd_b_f, 'odd_w_out': odd_w_out, 'ffn_w_up': ffn_w_up,
            'ffn_conv_w': ffn_conv_w, 'ffn_w_down': ffn_w_down}


def reference(x, attn_norm_w, ffn_norm_w, final_norm_w, even_w_in, hgrn_lb_logits,
              hgrn_norm_w, ret_norm_w, even_w_out, odd_w_in, odd_b_f, odd_w_out,
              ffn_w_up, ffn_conv_w, ffn_w_down):
    S = x.shape[1]
    positions = jnp.arange(S)
    sm = jax.nn.softmax(hgrn_lb_logits.astype(jnp.float32), axis=0)
    lower_bounds = jnp.cumsum(sm, axis=0) - sm[0:1]
    for layer in range(DEPTH):
        j = layer // 2
        h = rmsnorm(x, attn_norm_w[layer])
        if layer % 2 == 0:
            x = x + even_mixer(h, even_w_in[j], lower_bounds[j], hgrn_norm_w[j],
                               ret_norm_w[j], even_w_out[j], positions)
        else:
            x = x + fox_mixer(h, odd_w_in[j], odd_b_f[j], odd_w_out[j])
        h = rmsnorm(x, ffn_norm_w[layer])
        x = x + conv_ffn(h, ffn_w_up[layer], ffn_conv_w[layer], ffn_w_down[layer])
    return rmsnorm(x, final_norm_w)
```

```cpp
#include <hip/hip_runtime.h>
#include <cstdio>
#include <cstdint>
#define MK_N_LAUNCHES 1
namespace pg8 {
#define PG8_LAS __attribute__((address_space(3)))
typedef unsigned short bf16_t;
typedef short bf16x8 __attribute__((ext_vector_type(8)));
typedef float f32x4 __attribute__((ext_vector_type(4)));
typedef unsigned u32x4 __attribute__((ext_vector_type(4)));
constexpr int BM = 256, BK = 64, HALF = 128, HTB = HALF * BK * 2  , STAGE_BYTES = 8 * HTB, NXCD = 8, WGM = 8;

__host__ __device__ __forceinline__ int lds_byte(int r, int c) { const int st = (r >> 4) * 2 + (c >> 5), rr = r & 15, cc = c & 31, ob = rr * 64 + cc * 2; return st * 1024 + (ob ^ (((ob >> 9) & 1) << 5)); }
__host__ __device__ __forceinline__ void stage_rc(int b, int& R, int& C) { const int st = b / 1024, sb = b % 1024, swz = sb ^ (((sb >> 9) & 1) << 5); R = (st >> 1) * 16 + swz / 64; C = (st & 1) * 32 + (swz % 64) / 2; }
__host__ __device__ __forceinline__ int perm32(int rho) { const int n = rho >> 4, i = rho & 15; return 8 * (i >> 2) + 4 * n + (i & 3); }

struct Unit { int pm, pn; };
struct Gemm { const bf16_t* A; const bf16_t* Bt; int M, N, K; };

struct StaticOrder {
    int nM, nN, nwg, G, c;
    __host__ __device__ void init(int M, int N, int G_, int c_) { nM = M / BM; nN = N / BM; nwg = nM * nN; G = G_; c = c_; }
    __host__ __device__ __forceinline__ bool next(int i, Unit& u) const {
        const long L = (long)i * G + c; if (L >= nwg) return false;
        int wgid = (int)L; { const int q = nwg / NXCD, r = nwg % NXCD, xcd = wgid % NXCD, off = wgid / NXCD; wgid = (xcd < r ? xcd * (q + 1) : r * (q + 1) + (xcd - r) * q) + off; }
        const int nig = WGM * nN, gid = wgid / nig, fm = gid * WGM, gsz = (nM - fm) < WGM ? (nM - fm) : WGM;
        u.pm = fm + ((wgid % nig) % gsz); u.pn = (wgid % nig) / gsz; return true;
    }
    __device__ __forceinline__ void a_ready(const Unit&) const {}
    __device__ __forceinline__ void done(const Unit&) const {}
};
__device__ __forceinline__ int lane_now() { int l; asm volatile("v_mbcnt_lo_u32_b32 %0, -1, 0\n\tv_mbcnt_hi_u32_b32 %0, -1, %0" : "=v"(l)); return l; }
__device__ __forceinline__ float shfl_xor_l(float v, int m, int lane) { return __builtin_bit_cast(float, __builtin_amdgcn_ds_bpermute((lane ^ m) << 2, __builtin_bit_cast(int, v))); }
__device__ __forceinline__ float shfl_up_l(float v, int d, int lane) { return __builtin_bit_cast(float, __builtin_amdgcn_ds_bpermute((lane - d) << 2, __builtin_bit_cast(int, v))); }
__device__ __forceinline__ unsigned cvt_pk_bf16(float lo, float hi) { unsigned r; asm volatile("s_nop 0\n\tv_cvt_pk_bf16_f32 %0, %1, %2" : "=v"(r) : "v"(lo), "v"(hi)); return r; }
typedef float cvt_f32x2 __attribute__((ext_vector_type(2)));
typedef __bf16 cvt_bf16x2 __attribute__((ext_vector_type(2)));
__device__ __forceinline__ unsigned cvt_pk_bf16_c(float lo, float hi) { const cvt_bf16x2 v = __builtin_convertvector((cvt_f32x2){lo, hi}, cvt_bf16x2); return __builtin_bit_cast(unsigned, v); }
typedef unsigned u32x2 __attribute__((ext_vector_type(2)));
typedef float f32x2 __attribute__((ext_vector_type(2)));
typedef _Float16 h16x8 __attribute__((ext_vector_type(8)));
constexpr int EM = 16384, ED = 2048;
constexpr float RMS_EPS = 1e-6f;
__device__ __forceinline__ float fsigmoid(float x) { return __builtin_amdgcn_rcpf(1.f + __expf(-x)); }
__device__ __forceinline__ float row_rstd(const float* rsp, int row, int fq) { const f32x4 a = *(const f32x4*)(rsp + (size_t)row * 32 + fq * 8), b = *(const f32x4*)(rsp + (size_t)row * 32 + fq * 8 + 4);
    float s = ((a[0] + a[1]) + (a[2] + a[3])) + ((b[0] + b[1]) + (b[2] + b[3])); { const int l_ = lane_now(); s += shfl_xor_l(s, 16, l_); s += shfl_xor_l(s, 32, l_); } return __builtin_amdgcn_rsqf(s * (1.0f / (float)ED) + RMS_EPS); }
struct RstdLds { const PG8_LAS float* tab; };
__device__ __forceinline__ void rstd_get8(const RstdLds& R, int rloc0, float (&r)[2][4]) {
#pragma unroll
    for (int ai = 0; ai < 2; ++ai)
#pragma unroll
        for (int m = 0; m < 4; ++m) r[ai][m] = R.tab[rloc0 + ai * HALF + m * 16];
}
__device__ __forceinline__ u32x4 pack8f(const float (&v)[8]) { u32x4 w; w.x = cvt_pk_bf16(v[0], v[1]); w.y = cvt_pk_bf16(v[2], v[3]); w.z = cvt_pk_bf16(v[4], v[5]); w.w = cvt_pk_bf16(v[6], v[7]); return w; }

struct EpiResid {
    static constexpr bool PERM = true, AFTER_DRAIN = false;
    bf16_t* xb; float* rs;
    __device__ __forceinline__ void operator()(const f32x4 (&acc)[2][2][4][2], const Unit& u, int wr, int wc, int fr, int fq) const {
        const int row0 = u.pm * BM + wr * 64 + fr, col0 = u.pn * BM + wc * 32 + 8 * fq;
#pragma unroll
        for (int ai = 0; ai < 2; ++ai) {
            u32x4 xo[4][2];
#pragma unroll
            for (int m = 0; m < 4; ++m)
#pragma unroll
                for (int bj = 0; bj < 2; ++bj) xo[m][bj] = *(const u32x4*)(xb + (size_t)(row0 + ai * HALF + m * 16) * ED + col0 + bj * HALF);
#pragma unroll
            for (int m = 0; m < 4; ++m) { const int row = row0 + ai * HALF + m * 16; bf16_t* rowp = xb + (size_t)row * ED + col0; float ss = 0.f;
#pragma unroll
                for (int bj = 0; bj < 2; ++bj) { float v[8];
#pragma unroll
                    for (int e = 0; e < 4; ++e) { v[2 * e] = __uint_as_float(xo[m][bj][e] << 16) + acc[ai][bj][m][e >> 1][(2 * e) & 3]; v[2 * e + 1] = __uint_as_float(xo[m][bj][e] & 0xffff0000u) + acc[ai][bj][m][e >> 1][(2 * e + 1) & 3]; }
#pragma unroll
                    for (int e = 0; e < 8; ++e) ss += v[e] * v[e];
                    *(u32x4*)(rowp + bj * HALF) = pack8f(v); }
                { const int l_ = lane_now(); ss += shfl_xor_l(ss, 16, l_); ss += shfl_xor_l(ss, 32, l_); }
                if (fq == 0) rs[(size_t)row * 32 + u.pn * 4 + wc] = ss; }
            asm volatile("" ::: "memory"); }
    }
};
struct EpiUp {
    static constexpr bool PERM = true, AFTER_DRAIN = false;
    bf16_t* O; int ldc; const float* rs;
    __device__ __forceinline__ void operator()(const f32x4 (&acc)[2][2][4][2], const Unit& u, int wr, int wc, int fr, int fq) const {
        const int row0 = u.pm * BM + wr * 64 + fr, col0 = u.pn * BM + wc * 32 + 8 * fq;
#pragma unroll
        for (int ai = 0; ai < 2; ++ai)
#pragma unroll
            for (int m = 0; m < 4; ++m) { const int row = row0 + ai * HALF + m * 16; const float rstd = row_rstd(rs, row, fq); bf16_t* rowp = O + (size_t)row * ldc + col0;
#pragma unroll
                for (int bj = 0; bj < 2; ++bj) { const f32x4 v0 = acc[ai][bj][m][0] * rstd, v1 = acc[ai][bj][m][1] * rstd;
                    u32x4 w; w.x = cvt_pk_bf16(v0[0], v0[1]); w.y = cvt_pk_bf16(v0[2], v0[3]); w.z = cvt_pk_bf16(v1[0], v1[1]); w.w = cvt_pk_bf16(v1[2], v1[3]);
                    *(u32x4*)(rowp + bj * HALF) = w; } }
    }
};
__device__ __forceinline__ float dpp_prev1(float x, float p) { const int r = __builtin_amdgcn_update_dpp(0, __builtin_bit_cast(int, p), 0x121, 0xf, 0xf, false); return __builtin_bit_cast(float, __builtin_amdgcn_update_dpp(r, __builtin_bit_cast(int, x), 0x111, 0xf, 0xf, false)); }
__device__ __forceinline__ float dpp_prev2(float x, float p) { const int r = __builtin_amdgcn_update_dpp(0, __builtin_bit_cast(int, p), 0x122, 0xf, 0xf, false); return __builtin_bit_cast(float, __builtin_amdgcn_update_dpp(r, __builtin_bit_cast(int, x), 0x112, 0xf, 0xf, false)); }
struct EpiUpConv {
    static constexpr bool PERM = true, AFTER_DRAIN = false;
    bf16_t* act; float* sb; RstdLds rl; const float* cw; PG8_LAS float* halo;
    __device__ __forceinline__ void operator()(const f32x4 (&acc)[2][2][4][2], const Unit& u, int wr, int wc, int fr, int fq) const {
        const int row0 = u.pm * BM + wr * 64 + fr, cl = wc * 32 + 8 * fq, ccol = u.pn * 128 + cl;
        float rstd[2][4];
        rstd_get8(rl, wr * 64 + fr, rstd);
#pragma unroll
        for (int ai = 0; ai < 2; ++ai) { if (fr >= 14) { PG8_LAS float* hp = halo + ((2 * ai + wr) * 2 + (fr - 14)) * 256 + cl;
#pragma unroll
                for (int bj = 0; bj < 2; ++bj) { *(PG8_LAS f32x4*)(hp + bj * 128) = acc[ai][bj][3][0] * rstd[ai][3]; *(PG8_LAS f32x4*)(hp + bj * 128 + 4) = acc[ai][bj][3][1] * rstd[ai][3]; } } }
        if (wr == 0 && fr < 2) { float* sp = sb + ((size_t)(u.pm * 4 + fr)) * 11008 + u.pn * 256 + cl;
#pragma unroll
            for (int bj = 0; bj < 2; ++bj) { *(f32x4*)(sp + bj * 128) = acc[0][bj][0][0] * rstd[0][0]; *(f32x4*)(sp + bj * 128 + 4) = acc[0][bj][0][1] * rstd[0][0]; } }
        if (wr == 1 && fr >= 14) { float* sp = sb + ((size_t)(u.pm * 4 + 2 + (fr - 14))) * 11008 + u.pn * 256 + cl;
#pragma unroll
            for (int bj = 0; bj < 2; ++bj) { *(f32x4*)(sp + bj * 128) = acc[1][bj][3][0] * rstd[1][3]; *(f32x4*)(sp + bj * 128 + 4) = acc[1][bj][3][1] * rstd[1][3]; } }
        asm volatile("s_waitcnt lgkmcnt(0)" ::: "memory"); __builtin_amdgcn_s_barrier(); asm volatile("" ::: "memory");
        u32x2 pk0[2][4];
#pragma unroll
        for (int hf = 0; hf < 2; ++hf) {
            f32x2 w[3][4];
#pragma unroll
            for (int j = 0; j < 3; ++j) { const f32x4 a = *(const f32x4*)(cw + j * 11008 + ccol + 4 * hf), c = *(const f32x4*)(cw + j * 11008 + 5504 + ccol + 4 * hf);
#pragma unroll
                for (int e = 0; e < 4; ++e) w[j][e] = (f32x2){a[e], c[e]}; }
#pragma unroll
            for (int ai = 0; ai < 2; ++ai) {
                f32x2 p[4];
                const int sprev = 2 * ai + wr - 1;
                if (sprev >= 0 && fr >= 14) { const PG8_LAS float* hp = halo + (sprev * 2 + (fr - 14)) * 256 + cl + 4 * hf;
                    const f32x4 a = *(const PG8_LAS f32x4*)hp, c = *(const PG8_LAS f32x4*)(hp + 128);
#pragma unroll
                    for (int e = 0; e < 4; ++e) p[e] = (f32x2){a[e], c[e]}; }
                else {
#pragma unroll
                    for (int e = 0; e < 4; ++e) p[e] = (f32x2){0.f, 0.f}; }
#pragma unroll
                for (int m = 0; m < 4; ++m) { float o[4];
#pragma unroll
                    for (int e = 0; e < 4; ++e) { const f32x2 x0 = (f32x2){acc[ai][0][m][hf][e], acc[ai][1][m][hf][e]} * rstd[ai][m];
                        const f32x2 x1 = (f32x2){dpp_prev1(x0.x, p[e].x), dpp_prev1(x0.y, p[e].y)}, x2 = (f32x2){dpp_prev2(x0.x, p[e].x), dpp_prev2(x0.y, p[e].y)};
                        const f32x2 c = w[0][e] * x2 + w[1][e] * x1 + w[2][e] * x0;
                        o[e] = c.x * fsigmoid(c.x) * c.y; p[e] = x0; }
                    u32x2 w2; w2.x = cvt_pk_bf16(o[0], o[1]); w2.y = cvt_pk_bf16(o[2], o[3]);
                    if (hf == 0) pk0[ai][m] = w2;
                    else { u32x4 w4; w4.x = pk0[ai][m].x; w4.y = pk0[ai][m].y; w4.z = w2.x; w4.w = w2.y; *(u32x4*)(act + (size_t)(row0 + ai * HALF + m * 16) * 5504 + ccol) = w4; } }
            }
        }
    }
};
struct EpiEven {
    static constexpr bool PERM = true, AFTER_DRAIN = false;
    bf16_t* proj; _Float16* logf; RstdLds rl; const float* lbl;
    int jl;
    __device__ __forceinline__ void operator()(const f32x4 (&acc)[2][2][4][2], const Unit& u, int wr, int wc, int fr, int fq) const {
        const int seg = u.pn >> 2, cs0 = (u.pn & 3) * 256 + wc * 32 + 8 * fq, row0 = u.pm * BM + wr * 64 + fr;
        const size_t ho0 = (size_t)((u.pn & 3) * 2) * EM * 128 + wc * 32 + 8 * fq;
        bf16_t* segp = proj + (size_t)seg * EM * 1024;
        float rstd8[2][4];
        rstd_get8(rl, wr * 64 + fr, rstd8);
        if (seg == 1) {
            float lb[2][8];
#pragma unroll
            for (int bj = 0; bj < 2; ++bj)
#pragma unroll
                for (int e = 0; e < 8; ++e) { const int c = cs0 + bj * HALF + e; lb[bj][e] = jl ? fsigmoid(lbl[1024 + c] - lbl[c]) : 0.f; }
#pragma unroll
            for (int ai = 0; ai < 2; ++ai)
#pragma unroll
                for (int m = 0; m < 4; ++m) { const int row = row0 + ai * HALF + m * 16; const float rstd = rstd8[ai][m];
#pragma unroll
                    for (int bj = 0; bj < 2; ++bj) { h16x8 lh;
#pragma unroll
                        for (int e = 0; e < 8; ++e) { const float z = fminf(fmaxf(acc[ai][bj][m][e >> 2][e & 3] * rstd, -80.f), 80.f), ez = __expf(-z), sg = __builtin_amdgcn_rcpf(1.f + ez);
                            const float one_m = 1.f - lb[bj][e], f = fmaxf(lb[bj][e], 1e-30f) + one_m * sg, lf = __logf(f);
                            lh[e] = (_Float16)lf; }
                        const size_t o = ho0 + ((size_t)bj * EM + row) * 128;
                        *(h16x8*)(logf + o) = lh; } }
        } else if (seg == 4 || seg == 5) {
            const float sc = seg == 5 ? 0.08838834764831845f : 1.f;
            float invf[4];
#pragma unroll
            for (int i = 0; i < 4; ++i) invf[i] = exp2f(-(float)(wc * 16 + 4 * fq + i) * (13.287712379549449f / 64.f));
#pragma unroll
            for (int ai = 0; ai < 2; ++ai)
#pragma unroll
                for (int m = 0; m < 4; ++m) { const int row = row0 + ai * HALF + m * 16; const float rstd = rstd8[ai][m] * sc, tpos = (float)(row & 4095);
                    float cs[4], sn[4];
#pragma unroll
                    for (int i = 0; i < 4; ++i) { float rev = (tpos * invf[i]) * 0.15915494309189535f; rev = rev - floorf(rev); cs[i] = __builtin_amdgcn_cosf(rev); sn[i] = __builtin_amdgcn_sinf(rev); }
#pragma unroll
                    for (int bj = 0; bj < 2; ++bj) { float v[8];
#pragma unroll
                        for (int i = 0; i < 4; ++i) { const float x1 = acc[ai][bj][m][i >> 1][(2 * i) & 3] * rstd, x2 = acc[ai][bj][m][i >> 1][(2 * i + 1) & 3] * rstd;
                            v[2 * i] = x1 * cs[i] - x2 * sn[i]; v[2 * i + 1] = x2 * cs[i] + x1 * sn[i]; }
                        *(u32x4*)(segp + ho0 + ((size_t)bj * EM + row) * 128) = pack8f(v); } }
        } else {
            const bool act = (seg == 0 || seg == 3 || seg == 7);
#pragma unroll
            for (int ai = 0; ai < 2; ++ai)
#pragma unroll
                for (int m = 0; m < 4; ++m) { const int row = row0 + ai * HALF + m * 16; const float rstd = rstd8[ai][m];
#pragma unroll
                    for (int bj = 0; bj < 2; ++bj) { float v[8];
#pragma unroll
                        for (int e = 0; e < 8; ++e) { const float x = acc[ai][bj][m][e >> 2][e & 3] * rstd; v[e] = act ? x * fsigmoid(x) : x; }
                        *(u32x4*)(segp + ho0 + ((size_t)bj * EM + row) * 128) = pack8f(v); } }
        }
    }
};
struct EpiOdd {
    static constexpr bool PERM = true, AFTER_DRAIN = false;
    bf16_t* qkv; bf16_t* g; RstdLds rl;
    unsigned* nrm;
    PG8_LAS float* ex;
    __device__ __forceinline__ void operator()(const f32x4 (&acc)[2][2][4][2], const Unit& u, int wr, int wc, int fr, int fq) const {
        const int seg = u.pn >> 3, hh0 = (u.pn & 7) * 2, p0 = wc * 32 + 8 * fq, row0 = u.pm * BM + wr * 64 + fr;
        float rstd8[2][4];
        rstd_get8(rl, wr * 64 + fr, rstd8);
#pragma unroll
        for (int ai = 0; ai < 2; ++ai)
#pragma unroll
            for (int m = 0; m < 4; ++m) { const int row = row0 + ai * HALF + m * 16; const float rstd = rstd8[ai][m]; const int b = row >> 12, t = row & 4095;
#pragma unroll
                for (int bj = 0; bj < 2; ++bj) { float v[8]; const int hh = hh0 + bj;
#pragma unroll
                    for (int e = 0; e < 8; ++e) { const float x = acc[ai][bj][m][e >> 2][e & 3] * rstd; v[e] = (seg == 3) ? fsigmoid(x) : x; }
                    bf16_t* dst = (seg == 3) ? g + (size_t)row * ED + hh * 128 + p0 : qkv + (size_t)seg * EM * ED + ((size_t)(b * 16 + hh) * 4096 + t) * 128 + p0;
                    *(u32x4*)dst = pack8f(v);
                    if (seg < 2) { float s = 0.f;
#pragma unroll
                        for (int e = 0; e < 8; ++e) s += v[e] * v[e];
                        { const int l_ = lane_now(); s += shfl_xor_l(s, 16, l_); s += shfl_xor_l(s, 32, l_); }
                        if (fq == 0) ex[(wc * 2 + bj) * 256 + ai * HALF + wr * 64 + m * 16 + fr] = s; } } }
        if (seg < 2) {
            asm volatile("s_waitcnt lgkmcnt(0)" ::: "memory"); __builtin_amdgcn_s_barrier(); asm volatile("" ::: "memory");
            const int bj = wr, rl_ = wc * 64 + fq * 16 + fr;
            float s = (ex[(0 * 2 + bj) * 256 + rl_] + ex[(1 * 2 + bj) * 256 + rl_]) + (ex[(2 * 2 + bj) * 256 + rl_] + ex[(3 * 2 + bj) * 256 + rl_]);
            { const int l_ = lane_now();
#pragma unroll
              for (int o = 1; o < 64; o <<= 1) s = fmaxf(s, shfl_xor_l(s, o, l_)); }
            if (fr == 0 && fq == 0) atomicMax(nrm + (seg * 64 + (u.pm >> 4) * 16 + hh0 + bj) * 4, __float_as_uint(s)); }
    }
};

struct EpiNull {
    static constexpr bool PERM = false, AFTER_DRAIN = false;
    float* sink;
    __device__ __forceinline__ void operator()(const f32x4 (&acc)[2][2][4][2], const Unit& u, int wr, int wc, int fr, int fq) const {
        float s = 0.f;
#pragma unroll
        for (int ai = 0; ai < 2; ++ai)
#pragma unroll
            for (int bj = 0; bj < 2; ++bj)
#pragma unroll
                for (int m = 0; m < 4; ++m)
#pragma unroll
                    for (int n = 0; n < 2; ++n) s += (acc[ai][bj][m][n][0] + acc[ai][bj][m][n][1]) + (acc[ai][bj][m][n][2] + acc[ai][bj][m][n][3]);
        if (s == 123456.789f) sink[0] = s;
    }
};

template <int MODE> struct EpiProbe {
    static constexpr bool PERM = true, AFTER_DRAIN = false;
    bf16_t* qkv; bf16_t* g; const float* rs;
    __device__ __forceinline__ void operator()(const f32x4 (&acc)[2][2][4][2], const Unit& u, int wr, int wc, int fr, int fq) const {
        const int seg = u.pn >> 3, hh0 = (u.pn & 7) * 2, p0 = wc * 32 + 8 * fq, row0 = u.pm * BM + wr * 64 + fr;
        float sink = 0.f;
#pragma unroll
        for (int ai = 0; ai < 2; ++ai)
#pragma unroll
            for (int m = 0; m < 4; ++m) { const int row = row0 + ai * HALF + m * 16; const float rstd = MODE == 2 ? row_rstd(rs, row, fq) : (MODE == 3 ? 1.0001f : 1.f); const int b = row >> 12, t = row & 4095;
#pragma unroll
                for (int bj = 0; bj < 2; ++bj) { float v[8]; const int hh = hh0 + bj;
#pragma unroll
                    for (int e = 0; e < 8; ++e) { const float x = acc[ai][bj][m][e >> 2][e & 3] * rstd; v[e] = (MODE >= 2 && seg == 3) ? fsigmoid(x) : x; }
                    bf16_t* dst = (seg == 3) ? g + (size_t)row * ED + hh * 128 + p0 : qkv + (size_t)seg * EM * ED + ((size_t)(b * 16 + hh) * 4096 + t) * 128 + p0;
                    const u32x4 w = pack8f(v);
                    if (MODE == 1) *(u32x4*)dst = w; else sink += __uint_as_float(w.x ^ w.y ^ w.z ^ w.w); } }
        if (MODE >= 2 && sink == 123456.789f) qkv[0] = 1;
    }
};
template <class Epi, class Sched, bool ALIGN_EPI = false, bool SP2 = false>
__device__ __forceinline__ void gemm_phase(PG8_LAS unsigned char* lds, const Gemm g, const Sched& S, const Epi& E) {
    int tid_ = threadIdx.x; asm volatile("" : "+v"(tid_));
    const int tid = tid_, wid = __builtin_amdgcn_readfirstlane(tid >> 6), lane = tid & 63, wr = wid >> 2, wc = wid & 3, fr = lane & 15, fq = lane >> 4;
    const int K = g.K, nt = K / BK;
    unsigned voffA[2], voffB[2];
#pragma unroll
    for (int i = 0; i < 2; ++i) { int R, C; stage_rc(tid * 16 + i * 8192, R, C); const int Rb = Epi::PERM ? ((R & ~31) + perm32(R & 31)) : R;
        voffA[i] = (unsigned)(R * K + C) * 2u; voffB[i] = (unsigned)(Rb * K + C) * 2u; }
    const size_t kstep = (size_t)(BK * 2);
    const size_t hstep = (size_t)HALF * K * 2;
    const size_t tstep = 2 * hstep;
    const unsigned ldsw = (unsigned)wid * 1024u;
    const int aoff = lds_byte(wr * 64 + fr, fq * 8), boff = lds_byte(wc * 32 + fr, fq * 8);
#define PG8_SA(b, h) (((b) * 2 + (h)) * HTB)
#define PG8_SB(b, h) ((4 + (b) * 2 + (h)) * HTB)
#define PG8_STAGE(bufoff, gbase, voff) do { _Pragma("unroll") for (int _i = 0; _i < 2; ++_i) \
        __builtin_amdgcn_global_load_lds((const unsigned*)((const char*)(gbase) + (voff)[_i]), (PG8_LAS unsigned*)(lds + (bufoff) + ldsw + _i * 8192), 16, 0, 0); } while (0)
#define PG8_LDA(dst, b, h) do { _Pragma("unroll") for (int m = 0; m < 4; ++m) _Pragma("unroll") for (int k = 0; k < 2; ++k) dst[m][k] = *(const PG8_LAS bf16x8*)(lds + PG8_SA(b, h) + aoff + m * 2048 + k * 1024); } while (0)
#define PG8_LDB(dst, b, h) do { _Pragma("unroll") for (int n = 0; n < 2; ++n) _Pragma("unroll") for (int k = 0; k < 2; ++k) dst[n][k] = *(const PG8_LAS bf16x8*)(lds + PG8_SB(b, h) + boff + n * 2048 + k * 1024); } while (0)
#define PG8_MMA(ai, bj, At, Bt) do { __builtin_amdgcn_s_setprio(1); _Pragma("unroll") for (int m = 0; m < 4; ++m) _Pragma("unroll") for (int n = 0; n < 2; ++n) _Pragma("unroll") for (int k = 0; k < 2; ++k) \
        acc[ai][bj][m][n] = __builtin_amdgcn_mfma_f32_16x16x32_bf16(Bt[n][k], At[m][k], acc[ai][bj][m][n], 0, 0, 0); __builtin_amdgcn_s_setprio(0); } while (0)
#define PG8_WAIT_V(n) asm volatile("s_waitcnt vmcnt(" #n ")" ::: "memory")
#define PG8_WAIT_L(n) asm volatile("s_waitcnt lgkmcnt(" #n ")" ::: "memory")
#define PG8_BAR __builtin_amdgcn_s_barrier()
#define PG8_SCHED __builtin_amdgcn_sched_barrier(0)
    Unit cur, nxt; int ui = 0;
    if (!S.next(0, cur)) return;
    f32x4 acc[2][2][4][2];
#pragma unroll
    for (int a = 0; a < 2; ++a)
#pragma unroll
        for (int b = 0; b < 2; ++b)
#pragma unroll
            for (int m = 0; m < 4; ++m)
#pragma unroll
                for (int n = 0; n < 2; ++n) acc[a][b][m][n] = (f32x4){0.f, 0.f, 0.f, 0.f};
    bf16x8 At[4][2], B0[2][2], B1[2][2];
    const char* cA = (const char*)g.A + (size_t)cur.pm * tstep; const char* cB = (const char*)g.Bt + (size_t)cur.pn * tstep;
    S.a_ready(cur);
    if constexpr (SP2) {
        PG8_STAGE(PG8_SB(0, 0), cB, voffB); PG8_STAGE(PG8_SB(0, 1), cB + hstep, voffB); PG8_STAGE(PG8_SA(0, 0), cA, voffA); PG8_STAGE(PG8_SA(0, 1), cA + hstep, voffA);
        if (wr == 1) PG8_BAR;
        PG8_WAIT_V(2); PG8_BAR;
        PG8_STAGE(PG8_SB(1, 0), cB + kstep, voffB); PG8_STAGE(PG8_SA(1, 0), cA + kstep, voffA); PG8_STAGE(PG8_SB(1, 1), cB + hstep + kstep, voffB);
        PG8_WAIT_V(6); PG8_BAR;
    } else {
        PG8_STAGE(PG8_SB(0, 0), cB, voffB); PG8_STAGE(PG8_SA(0, 0), cA, voffA); PG8_STAGE(PG8_SB(0, 1), cB + hstep, voffB); PG8_STAGE(PG8_SA(0, 1), cA + hstep, voffA);
        if (wr == 1) PG8_BAR;
        PG8_WAIT_V(4); PG8_BAR;
        PG8_STAGE(PG8_SB(1, 0), cB + kstep, voffB); PG8_STAGE(PG8_SA(1, 0), cA + kstep, voffA); PG8_STAGE(PG8_SB(1, 1), cB + hstep + kstep, voffB);
        PG8_WAIT_V(6); PG8_BAR;
    }
    for (;;) {
        const bool has_next = S.next(ui + 1, nxt);
        const char* nA = has_next ? (const char*)g.A + (size_t)nxt.pm * tstep : cA; const char* nB = has_next ? (const char*)g.Bt + (size_t)nxt.pn * tstep : cB;
        for (int t = 0; t < nt; t += 2) {
            const bool last = (t == nt - 2);
            const char* a1 = cA + (size_t)(t + 1) * kstep;
            const char* a2 = last ? nA : cA + (size_t)(t + 2) * kstep; const char* b2 = last ? nB : cB + (size_t)(t + 2) * kstep;
            const char* a3 = a2 + kstep; const char* b3 = b2 + kstep;
            if (last && has_next) S.a_ready(nxt);
            if constexpr (SP2) {
            PG8_LDB(B0, 0, 0); PG8_LDB(B1, 0, 1); PG8_SCHED; PG8_LDA(At, 0, 0); PG8_STAGE(PG8_SA(1, 1), a1 + hstep, voffA);
            PG8_WAIT_V(8); PG8_WAIT_L(0); PG8_BAR; PG8_MMA(0, 0, At, B0); PG8_MMA(0, 1, At, B1); PG8_BAR; PG8_SCHED;
            PG8_LDA(At, 0, 1); PG8_STAGE(PG8_SB(0, 0), b2, voffB); PG8_STAGE(PG8_SB(0, 1), b2 + hstep, voffB); PG8_STAGE(PG8_SA(0, 0), a2, voffA);
            PG8_WAIT_V(8); PG8_WAIT_L(0); PG8_BAR; PG8_MMA(1, 0, At, B0); PG8_MMA(1, 1, At, B1); PG8_BAR; PG8_SCHED;
            PG8_LDB(B0, 1, 0); PG8_LDB(B1, 1, 1); PG8_SCHED; PG8_LDA(At, 1, 0); PG8_STAGE(PG8_SA(0, 1), a2 + hstep, voffA);
            PG8_WAIT_V(8); PG8_WAIT_L(0); PG8_BAR; PG8_MMA(0, 0, At, B0); PG8_MMA(0, 1, At, B1); PG8_BAR; PG8_SCHED;
            PG8_LDA(At, 1, 1); PG8_STAGE(PG8_SB(1, 0), b3, voffB); PG8_STAGE(PG8_SB(1, 1), b3 + hstep, voffB); PG8_STAGE(PG8_SA(1, 0), a3, voffA);
            PG8_WAIT_V(8); PG8_WAIT_L(0); PG8_BAR; PG8_MMA(1, 0, At, B0); PG8_MMA(1, 1, At, B1); PG8_BAR; PG8_SCHED;
            } else {
            PG8_LDB(B0, 0, 0); PG8_SCHED; PG8_LDA(At, 0, 0); PG8_STAGE(PG8_SA(1, 1), a1 + hstep, voffA);
            PG8_WAIT_L(8); PG8_BAR; PG8_WAIT_L(0); PG8_MMA(0, 0, At, B0); PG8_BAR; PG8_SCHED;
            PG8_LDB(B1, 0, 1); PG8_STAGE(PG8_SB(0, 0), b2, voffB);
            PG8_BAR; PG8_WAIT_L(0); PG8_MMA(0, 1, At, B1); PG8_BAR;
            PG8_LDA(At, 0, 1); PG8_STAGE(PG8_SA(0, 0), a2, voffA);
            PG8_BAR; PG8_WAIT_L(0); PG8_MMA(1, 0, At, B0); PG8_BAR; PG8_SCHED;
            PG8_STAGE(PG8_SB(0, 1), b2 + hstep, voffB);
            PG8_WAIT_V(6); PG8_BAR; PG8_MMA(1, 1, At, B1); PG8_BAR;
            PG8_LDB(B0, 1, 0); PG8_SCHED; PG8_LDA(At, 1, 0); PG8_STAGE(PG8_SA(0, 1), a2 + hstep, voffA);
            PG8_WAIT_L(8); PG8_BAR; PG8_WAIT_L(0); PG8_MMA(0, 0, At, B0); PG8_BAR; PG8_SCHED;
            PG8_LDB(B1, 1, 1); PG8_STAGE(PG8_SB(1, 0), b3, voffB);
            PG8_BAR; PG8_WAIT_L(0); PG8_MMA(0, 1, At, B1); PG8_BAR;
            PG8_LDA(At, 1, 1); PG8_STAGE(PG8_SA(1, 0), a3, voffA);
            PG8_BAR; PG8_WAIT_L(0); PG8_MMA(1, 0, At, B0); PG8_BAR; PG8_SCHED;
            PG8_STAGE(PG8_SB(1, 1), b3 + hstep, voffB);
            PG8_WAIT_V(6); PG8_BAR; PG8_MMA(1, 1, At, B1); PG8_BAR;
            }
        }
        if constexpr (ALIGN_EPI) { if (wr == 0) PG8_BAR; }
        if constexpr (!Epi::AFTER_DRAIN) { E(acc, cur, wr, wc, fr, fq); S.done(cur); }
        if (!has_next) break;
#pragma unroll
        for (int a = 0; a < 2; ++a)
#pragma unroll
            for (int b = 0; b < 2; ++b)
#pragma unroll
                for (int m = 0; m < 4; ++m)
#pragma unroll
                    for (int n = 0; n < 2; ++n) acc[a][b][m][n] = (f32x4){0.f, 0.f, 0.f, 0.f};
        cur = nxt; cA = nA; cB = nB; ++ui;
        if constexpr (ALIGN_EPI) { if (wr == 1) PG8_BAR; }
    }
    PG8_WAIT_V(0);
    if constexpr (!ALIGN_EPI) { if (wr == 0) PG8_BAR; }
    PG8_BAR;
    if constexpr (Epi::AFTER_DRAIN) { E.fused(acc, cur, wr, wc, fr, fq, lds, wid, lane); S.done(cur); }
#undef PG8_SA
#undef PG8_SB
#undef PG8_STAGE
#undef PG8_LDA
#undef PG8_LDB
#undef PG8_MMA
#undef PG8_WAIT_V
#undef PG8_WAIT_L
#undef PG8_BAR
#undef PG8_SCHED
}
}
#include <hip/hip_bf16.h>
namespace fox {
enum { ORDER_NATURAL = 0, ORDER_REVERSED = 1, ORDER_PAIRED = 2, ORDER_XCD = 4 };
constexpr int B = 4, H = 16, HKV = 16, SQ = 4096, SKV = 4096, D = 128, QOFF = 0, WINDOW = SKV, OP = 2048;
constexpr float THR = 8.f;
constexpr int ORDER = ORDER_PAIRED;
constexpr bool WSKIP = false;
constexpr float SCALE = 0.08838834764831845f;
constexpr int NW = 8, QBLK = 32, KVBLK = 64, QB = NW * QBLK;
constexpr int SHM_V = KVBLK * D * 2, SHM_K = KVBLK * D * 2;
constexpr int LDS_BYTES = 2 * SHM_V + 2 * SHM_K + NW * 64 * 4;
constexpr int OST_OFF = LDS_BYTES, OST_BYTES = NW * 8192;
static_assert(D == 128 && SQ % QB == 0 && SKV % KVBLK == 0 && H % HKV == 0 && QOFF >= 0 && QOFF + SQ <= SKV && WINDOW >= 1, "geometry");

using bf16 = __hip_bfloat16;
typedef short bf16x8 __attribute__((ext_vector_type(8)));
typedef short s16x4 __attribute__((ext_vector_type(4)));
typedef float f32x16 __attribute__((ext_vector_type(16)));
typedef float f32x4 __attribute__((ext_vector_type(4)));
typedef unsigned u32x4 __attribute__((ext_vector_type(4)));
template <class A, class Bt> struct same_t { static constexpr bool v = false; };
template <class A> struct same_t<A, A> { static constexpr bool v = true; };

#define KSWZ(row, colB) ((row) * 256 + ((colB) ^ (((row) & 7) << 4)))
#define SBAR() __builtin_amdgcn_sched_barrier(0)
__device__ __forceinline__ int v_st(int k, int c) { const int kk = (k & ~0xC) | ((k & 4) << 1) | ((k & 8) >> 1); return ((kk >> 3) * 4 + (c >> 5)) * 512 + ((kk & 7) * 32 + (c & 31)) * 2; }
__device__ __forceinline__ int v_rd_base(int lane) { return ((lane & 3) << 3) | (((lane >> 2) & 3) << 6) | (((lane >> 4) & 1) << 5) | (((lane >> 5) & 1) << 8); }
constexpr int v_rd_off(int d0, int ks, int half) { return d0 * 512 + ks * 4096 + half * 2048; }
__device__ __forceinline__ int crow(int r, int hi) { return (r & 3) + 8 * (r >> 2) + 4 * hi; }
__device__ __forceinline__ unsigned cvtpk(float lo, float hi) {
    unsigned r; asm volatile("s_nop 0\n\tv_cvt_pk_bf16_f32 %0, %1, %2" : "=v"(r) : "v"(lo), "v"(hi)); return r;
}
__device__ __forceinline__ bf16x8 pack8(f32x4 a, f32x4 b) {
    u32x4 w = {cvtpk(a[0], a[1]), cvtpk(a[2], a[3]), cvtpk(b[0], b[1]), cvtpk(b[2], b[3])};
    return *reinterpret_cast<bf16x8*>(&w);
}
template <class T> __device__ __forceinline__ bf16x8 load8(const T* p) {
    if constexpr (same_t<T, float>::v) { return pack8(*(const f32x4*)p, *(const f32x4*)(p + 4)); }
    else { return *reinterpret_cast<const bf16x8*>(p); }
}
__device__ __forceinline__ void mask_tile(f32x16& p0, f32x16& p1, int dq, unsigned W) {
    const float NEG = -__builtin_inff();
#pragma unroll
    for (int r = 0; r < 16; ++r) {
        const int c = (r & 3) + 8 * (r >> 2);
        if ((unsigned)(dq - c) >= W) p0[r] = NEG;
        if ((unsigned)(dq - c - 32) >= W) p1[r] = NEG;
    }
}
__device__ __forceinline__ void partialSM(f32x16& p0, f32x16& p1, float& m_reg, float& mn, float& alpha) {
    float pmax = p0[0]; for (int r = 1; r < 16; ++r) pmax = fmaxf(pmax, p0[r]); for (int r = 0; r < 16; ++r) pmax = fmaxf(pmax, p1[r]);
    { auto rr = __builtin_amdgcn_permlane32_swap(__float_as_uint(pmax), __float_as_uint(pmax), false, false);
      pmax = fmaxf(__uint_as_float(rr[0]), __uint_as_float(rr[1])); }
    constexpr float C2 = 1.4426950408889634f * SCALE;
    if (__builtin_expect(__all((pmax - m_reg) * SCALE <= THR), 1)) { mn = m_reg; alpha = 1.f; }
    else { mn = fmaxf(m_reg, pmax); alpha = __builtin_amdgcn_exp2f((m_reg - mn) * C2); m_reg = mn; }
    const float mnL = -mn * C2;
    for (int r = 0; r < 16; ++r) p0[r] = fmaf(p0[r], C2, mnL); for (int r = 0; r < 16; ++r) p1[r] = fmaf(p1[r], C2, mnL);
    for (int r = 0; r < 16; ++r) p0[r] = __builtin_amdgcn_exp2f(p0[r]);
}
__device__ __forceinline__ void finishSM(f32x16& p0, f32x16& p1, float alpha, float& l_reg, bf16x8& pa0, bf16x8& pa1, bf16x8& pa2, bf16x8& pa3) {
    for (int r = 0; r < 16; ++r) p1[r] = __builtin_amdgcn_exp2f(p1[r]);
    float ps = 0; for (int r = 0; r < 16; ++r) ps += p0[r]; for (int r = 0; r < 16; ++r) ps += p1[r];
    { auto rr = __builtin_amdgcn_permlane32_swap(__float_as_uint(ps), __float_as_uint(ps), false, false);
      ps = __uint_as_float(rr[0]) + __uint_as_float(rr[1]); }
    l_reg = l_reg * alpha + ps;
#define PK4(P, B_, OUT) do { unsigned a0 = cvtpk(P[B_+0], P[B_+1]), a1 = cvtpk(P[B_+2], P[B_+3]);                          \
        unsigned b0 = cvtpk(P[B_+4], P[B_+5]), b1 = cvtpk(P[B_+6], P[B_+7]);                                             \
        auto r0 = __builtin_amdgcn_permlane32_swap(a0, b0, false, false); auto r1 = __builtin_amdgcn_permlane32_swap(a1, b1, false, false); \
        u32x4 w = {r0[0], r1[0], r0[1], r1[1]}; OUT = *reinterpret_cast<bf16x8*>(&w); } while (0)
    PK4(p0, 0, pa0); PK4(p0, 8, pa1); PK4(p1, 0, pa2); PK4(p1, 8, pa3);
#undef PK4
}
template <int KB, bool SK>
__device__ __forceinline__ void qkt(f32x16& p0, f32x16& p1, const char* K_lds, int r32, int hi, const bf16x8* qr, bool act, const __attribute__((address_space(3))) float* csk) {
    if (SK && !act) { const float NEG = -__builtin_inff();
#pragma unroll
        for (int r = 0; r < 16; ++r) { p0[r] = NEG; p1[r] = NEG; } return; }
    {
        typedef __attribute__((address_space(3))) f32x4 lf4; const lf4* cb = (const lf4*)(csk + 4 * hi);
        const f32x4 a0 = cb[0], a1 = cb[2], a2 = cb[4], a3 = cb[6], b0 = cb[8], b1 = cb[10], b2 = cb[12], b3 = cb[14];
        p0 = __builtin_shufflevector(__builtin_shufflevector(a0, a1, 0, 1, 2, 3, 4, 5, 6, 7), __builtin_shufflevector(a2, a3, 0, 1, 2, 3, 4, 5, 6, 7), 0, 1, 2, 3, 4, 5, 6, 7, 8, 9, 10, 11, 12, 13, 14, 15);
        p1 = __builtin_shufflevector(__builtin_shufflevector(b0, b1, 0, 1, 2, 3, 4, 5, 6, 7), __builtin_shufflevector(b2, b3, 0, 1, 2, 3, 4, 5, 6, 7), 0, 1, 2, 3, 4, 5, 6, 7, 8, 9, 10, 11, 12, 13, 14, 15); }
    const char* kb[4];
#pragma unroll
    for (int dd = 0; dd < 4; ++dd) kb[dd] = K_lds + KB * SHM_K + KSWZ(r32, (dd * 16 + hi * 8) * 2);
#pragma unroll
    for (int d0 = 0; d0 < 8; ++d0) { const char* a = kb[d0 & 3] + (d0 >> 2) * 128;
        bf16x8 b0 = *reinterpret_cast<const bf16x8*>(a);
        bf16x8 b1 = *reinterpret_cast<const bf16x8*>(a + 32 * 256);
        p0 = __builtin_amdgcn_mfma_f32_32x32x16_bf16(b0, qr[d0], p0, 0, 0, 0);
        p1 = __builtin_amdgcn_mfma_f32_32x32x16_bf16(b1, qr[d0], p1, 0, 0, 0); }
}
template <int VB, bool SK>
__device__ __forceinline__ void pv_tile(f32x16* o, int vb0, bf16x8 pa0, bf16x8 pa1, bf16x8 pa2, bf16x8 pa3, bool act) {
    if (SK && !act) return;
#define TRRD(dst, off) asm volatile("ds_read_b64_tr_b16 %0, %1 offset:%2" : "=&v"(dst) : "v"(vb0), "i"(off) : "memory")
#define PV_D0(d0) do { s16x4 l0, l1, l2, l3, h0, h1, h2, h3; constexpr int b_ = VB * SHM_V + v_rd_off(d0, 0, 0);     \
        TRRD(l0, b_); TRRD(h0, b_ + 2048); TRRD(l1, b_ + 4096); TRRD(h1, b_ + 6144); TRRD(l2, b_ + 8192); TRRD(h2, b_ + 10240); TRRD(l3, b_ + 12288); TRRD(h3, b_ + 14336); \
        asm volatile("s_waitcnt lgkmcnt(0)" ::: "memory"); SBAR();                 \
        o[d0] = __builtin_amdgcn_mfma_f32_32x32x16_bf16(pa0, (bf16x8){l0[0], l0[1], l0[2], l0[3], h0[0], h0[1], h0[2], h0[3]}, o[d0], 0, 0, 0);   \
        o[d0] = __builtin_amdgcn_mfma_f32_32x32x16_bf16(pa1, (bf16x8){l1[0], l1[1], l1[2], l1[3], h1[0], h1[1], h1[2], h1[3]}, o[d0], 0, 0, 0);   \
        o[d0] = __builtin_amdgcn_mfma_f32_32x32x16_bf16(pa2, (bf16x8){l2[0], l2[1], l2[2], l2[3], h2[0], h2[1], h2[2], h2[3]}, o[d0], 0, 0, 0);   \
        o[d0] = __builtin_amdgcn_mfma_f32_32x32x16_bf16(pa3, (bf16x8){l3[0], l3[1], l3[2], l3[3], h3[0], h3[1], h3[2], h3[3]}, o[d0], 0, 0, 0); } while (0)
    PV_D0(0); PV_D0(1); PV_D0(2); PV_D0(3);
#undef PV_D0
#undef TRRD
}

template <class TIn, class TOut> struct BlockRef { const TIn* Q; const TIn* K; const TIn* V; TOut* O; int P0; float thr; };
template <class TIn> struct Seam {
    bf16x8 qr[8];
    bf16x8 st_v0, st_v1, st_k0, st_k1; f32x4 sf0, sf1, sf2, sf3;
    f32x4 tq[16];
};
__device__ __forceinline__ int swa_jlo(int P0, int W) { const int lowk = P0 - W + 1; return lowk > 0 ? lowk / KVBLK : 0; }
__device__ __forceinline__ int fox_jlo(const __attribute__((address_space(3))) float* ncs, int P0, float thr) {
    int l = threadIdx.x; asm volatile("" : "+v"(l)); l &= 63;
    float e = 3.2086e-10f * __expf(fminf((thr - (ncs[P0] - ncs[64 * l + 63])) * 0.08838834764831845f, 80.f));
#pragma unroll
    for (int o = 1; o < 64; o <<= 1) { const float u = pg8::shfl_up_l(e, o, l); e += (l >= o) ? u : 0.f; }
    return __builtin_amdgcn_readfirstlane(__builtin_ctzll(__ballot(e >= 3e-8f)));
}
#define ROW(p, k0, rr) ((p) + (size_t)((k0) + (rr)) * D + sc)
#define VMW() asm volatile("s_waitcnt vmcnt(0)" ::: "memory")
#define VMWN(n) asm volatile("s_waitcnt vmcnt(%0)" :: "i"(n) : "memory")
#define SLOAD_H(Kp, Vp, k0) do { S.st_v0 = load8<TIn>(ROW(Vp, k0, sr)); S.st_v1 = load8<TIn>(ROW(Vp, k0, 32 + sr));              \
                         S.st_k0 = load8<TIn>(ROW(Kp, k0, sr)); S.st_k1 = load8<TIn>(ROW(Kp, k0, 32 + sr)); } while (0)
#define SWRITE_HK(bf) do { *(bf16x8*)(K_lds + (bf) * SHM_K + kws) = S.st_k0; *(bf16x8*)(K_lds + (bf) * SHM_K + kws + 32 * 256) = S.st_k1; } while (0)
#define SWRITE_HV(bf) do { *(bf16x8*)(V_lds + (bf) * SHM_V + vst0) = S.st_v0; *(bf16x8*)(V_lds + (bf) * SHM_V + vst1) = S.st_v1; } while (0)
#define SWRITE_H(bf) do { SWRITE_HV(bf); SWRITE_HK(bf); } while (0)
#define SLOAD_F(p, k0) do { S.sf0 = *(const f32x4*)ROW(p, k0, sr); S.sf1 = *(const f32x4*)(ROW(p, k0, sr) + 4);                \
                            S.sf2 = *(const f32x4*)ROW(p, k0, 32 + sr); S.sf3 = *(const f32x4*)(ROW(p, k0, 32 + sr) + 4); } while (0)
#define SWRITE_KF(bf) do { *(bf16x8*)(K_lds + (bf) * SHM_K + kws) = pack8(S.sf0, S.sf1); *(bf16x8*)(K_lds + (bf) * SHM_K + kws + 32 * 256) = pack8(S.sf2, S.sf3); } while (0)
#define SWRITE_VF(bf) do { *(bf16x8*)(V_lds + (bf) * SHM_V + vst0) = pack8(S.sf0, S.sf1); *(bf16x8*)(V_lds + (bf) * SHM_V + vst1) = pack8(S.sf2, S.sf3); } while (0)
template <class TIn, class TOut>
__device__ __forceinline__ void causal_swa_prime(const BlockRef<TIn, TOut>& cur, int W, char* lds, Seam<TIn>& S, const __attribute__((address_space(3))) float* ncs) {
    constexpr bool F32 = same_t<TIn, float>::v;
    int tid_ = threadIdx.x; asm volatile("" : "+v"(tid_));
    const int tid = tid_, wid = __builtin_amdgcn_readfirstlane(tid >> 6), lane = tid & 63, r32 = lane & 31, hi = lane >> 5;
    const int sr = tid >> 4, sc = (tid & 15) * 8, kws = KSWZ(sr, sc * 2); char* K_lds = lds + 2 * SHM_V;
    const int kb0 = fox_jlo(ncs, cur.P0, cur.thr) * KVBLK;
    for (int d0 = 0; d0 < 8; ++d0) S.qr[d0] = load8<TIn>(cur.Q + (size_t)(wid * QBLK + r32) * D + d0 * 16 + hi * 8);
    if constexpr (F32) { SLOAD_F((const float*)cur.K, kb0); VMW(); SWRITE_KF(0); SBAR(); SLOAD_F((const float*)cur.V, kb0); }
    else { SLOAD_H(cur.K, cur.V, kb0); VMW(); SWRITE_HK(0); }
    __syncthreads();
}
template <class TIn, class TOut>
__device__ __forceinline__ void causal_swa_block(const BlockRef<TIn, TOut>& cur, const BlockRef<TIn, TOut>& nxt, int skv, int W, char* lds, Seam<TIn>& S, const __attribute__((address_space(3))) float* cs, long gdelta) {
    constexpr bool F32 = same_t<TIn, float>::v;
    int tid_ = threadIdx.x; asm volatile("" : "+v"(tid_));
    const int tid = tid_, wid = __builtin_amdgcn_readfirstlane(tid >> 6), lane = tid & 63, r32 = lane & 31, hi = lane >> 5;
    const int j_lo = fox_jlo(cs, cur.P0, cur.thr);
    int j_hi = (cur.P0 + QB - 1) / KVBLK + 1; if (j_hi > skv / KVBLK) j_hi = skv / KVBLK;
    const int NT = j_hi - j_lo;
    const int kbn = fox_jlo(cs, nxt.P0, nxt.thr) * KVBLK;
    const int qlo = cur.P0 + wid * QBLK, qm = qlo + r32 - 4 * hi;
    char* V_lds = lds; char* K_lds = lds + 2 * SHM_V;
    float* ws = (float*)(lds + 2 * SHM_V + 2 * SHM_K) + wid * 64; float* li_l = ws, * al_l = ws + 32;
    float m_reg = -1e30f, l_reg = 0; f32x16 o[4] = {};
    const int sr = tid >> 4, sc = (tid & 15) * 8, vst0 = v_st(sr, sc), vst1 = v_st(32 + sr, sc), kws = KSWZ(sr, sc * 2);
    const int vb0 = (int)(uintptr_t)V_lds + v_rd_base(lane);
    const TIn* Kh = cur.K; const TIn* Vh = cur.V;
#define RESC(a) do { if (__any((a) < 1.f)) { if (hi == 0) al_l[r32] = (a); asm volatile("s_waitcnt lgkmcnt(0)" ::: "memory");              \
                     for (int d_ = 0; d_ < 4; ++d_) for (int r = 0; r < 16; ++r) o[d_][r] *= al_l[crow(r, hi)]; } } while (0)
#define KBASE(t) ((j_lo + (t)) * KVBLK)
#define ACT(t) (KBASE(t) <= qlo + QBLK - 1 && KBASE(t) + KVBLK - 1 >= qlo - W + 1)
#define MASKT(P0_, P1_, t) do { const int kb_ = KBASE(t); if ((!SK || ACT(t)) && (kb_ + KVBLK - 1 > qlo || kb_ <= qlo + QBLK - 1 - W)) mask_tile(P0_, P1_, qm - kb_, (unsigned)W); } while (0)
    constexpr int NQL = F32 ? 16 : 8;
    constexpr bool SK = WSKIP && !F32;
#define SEAM_K0() do { VMWN(NQL); if constexpr (F32) { SWRITE_KF(0); SBAR(); SLOAD_F((const float*)nxt.V, kbn); } else { SWRITE_HK(0); } SBAR(); } while (0)
    f32x16 pA0, pA1, pB0, pB1; float mnA, mnB, alA, alB; bf16x8 pa0, pa1, pa2, pa3;
    if constexpr (F32) { VMW(); SWRITE_VF(0); SBAR(); } else { SWRITE_HV(0); SBAR(); }
    if (NT > 1) { if constexpr (F32) SLOAD_F((const float*)Kh, KBASE(1)); else SLOAD_H(Kh, Vh, KBASE(1)); }
    SBAR(); qkt<0, SK>(pA0, pA1, K_lds, r32, hi, S.qr, ACT(0), cs + KBASE(0));
    if constexpr (F32) { if (NT > 1) { VMW(); SWRITE_KF(1); SBAR(); SLOAD_F((const float*)Vh, KBASE(1)); } }
    MASKT(pA0, pA1, 0); partialSM(pA0, pA1, m_reg, mnA, alA);
    if (NT > 1) { VMW(); if constexpr (F32) { SWRITE_VF(1); SBAR(); if (NT > 2) SLOAD_F((const float*)Kh, KBASE(2)); } else SWRITE_H(1); }
    __syncthreads();
#define HALF_STEP(PX0, PX1, mnX, alX, PY0, PY1, alY, t, KB, VB, SB) do {                                                      \
        SBAR(); qkt<KB, SK>(PX0, PX1, K_lds, r32, hi, S.qr, ACT(t), cs + KBASE(t));                                             \
        finishSM(PY0, PY1, alY, l_reg, pa0, pa1, pa2, pa3); SBAR();                                                           \
        if ((t) + 1 < NT) { if constexpr (F32) { VMW(); SWRITE_KF(SB); SBAR(); SLOAD_F((const float*)Vh, KBASE((t) + 1)); }  \
                            else { SLOAD_H(Kh, Vh, KBASE((t) + 1)); } SBAR(); }                                               \
        pv_tile<VB, SK>(o, vb0, pa0, pa1, pa2, pa3, ACT((t) - 1)); MASKT(PX0, PX1, (t)); partialSM(PX0, PX1, m_reg, mnX, alX);                                        \
        __syncthreads();                                                                                                      \
        if ((t) + 1 < NT) { VMW(); if constexpr (F32) { SWRITE_VF(SB); SBAR(); if ((t) + 2 < NT) SLOAD_F((const float*)Kh, KBASE((t) + 2)); } \
                            else { SWRITE_H(SB); } }                                                                          \
        RESC(alX); __syncthreads(); } while (0)
    for (int t = 1; t + 1 < NT; t += 2) {
        HALF_STEP(pB0, pB1, mnB, alB, pA0, pA1, alA, t, 1, 0, 0);
        HALF_STEP(pA0, pA1, mnA, alA, pB0, pB1, alB, t + 1, 0, 1, 1);
    }
    int tt_ = threadIdx.x; asm volatile("" : "+v"(tt_));
    const int widb = __builtin_amdgcn_readfirstlane(tt_ >> 6), laneb = tt_ & 63, r32b = laneb & 31, hib = laneb >> 5;
    const bool even = (NT & 1) == 0;
    if (even) { SBAR(); qkt<1, SK>(pB0, pB1, K_lds, r32, hi, S.qr, ACT(NT - 1), cs + KBASE(NT - 1)); SBAR(); }
#define QROW(e) (nxt.Q + (size_t)(wid * QBLK + r32) * D + ((e) >> 1) * 16 + hi * 8 + ((e) & 1) * 4)
    if constexpr (F32) { SLOAD_F((const float*)nxt.K, kbn); SBAR();
#pragma unroll
        for (int e = 0; e < 8; ++e) S.tq[e] = *(const f32x4*)QROW(e); }
    else { SLOAD_H(nxt.K, nxt.V, kbn); SBAR();
#pragma unroll
        for (int d0 = 0; d0 < 8; ++d0) S.qr[d0] = load8<TIn>(nxt.Q + (size_t)(widb * QBLK + r32b) * D + d0 * 16 + hib * 8); }
    SBAR();
    finishSM(pA0, pA1, alA, l_reg, pa0, pa1, pa2, pa3); SBAR();
    if constexpr (F32) {
#pragma unroll
        for (int e = 8; e < 16; ++e) S.tq[e] = *(const f32x4*)QROW(e); SBAR(); }
#undef QROW
    pv_tile<0, SK>(o, vb0, pa0, pa1, pa2, pa3, ACT(even ? NT - 2 : NT - 1));
    if (even) { MASKT(pB0, pB1, NT - 1); partialSM(pB0, pB1, m_reg, mnB, alB); __syncthreads(); RESC(alB);
        finishSM(pB0, pB1, alB, l_reg, pa0, pa1, pa2, pa3); SBAR(); pv_tile<1, SK>(o, vb0, pa0, pa1, pa2, pa3, ACT(NT - 1)); }
    SBAR(); SEAM_K0();
    float* li_b = (float*)(lds + 2 * SHM_V + 2 * SHM_K) + widb * 64;
    if (hib == 0) li_b[r32b] = l_reg; asm volatile("s_waitcnt lgkmcnt(0)" ::: "memory");
    float rli[16];
#pragma unroll
    for (int r = 0; r < 16; ++r) rli[r] = __builtin_amdgcn_rcpf(li_b[crow(r, hib)]);
    {
        typedef __attribute__((address_space(3))) unsigned short lus; typedef __attribute__((address_space(3))) u32x4 lu4;
        const unsigned ost = (unsigned)(uintptr_t)lds + OST_OFF + widb * 8192;
#pragma unroll
        for (int r = 0; r < 16; ++r) { const int orow = crow(r, hib);
#pragma unroll
            for (int d0 = 0; d0 < 4; ++d0) { const float v = o[d0][r] * rli[r]; const unsigned w = cvtpk(v, v);
                *(lus*)(ost + orow * 256 + (d0 * 32 + r32b) * 2) = (unsigned short)w; } }
        asm volatile("s_waitcnt lgkmcnt(0)" ::: "memory");
        TOut* Ow = cur.O + (size_t)(widb * QBLK) * OP; const char* Gw = (const char*)Ow + gdelta;
#pragma unroll
        for (int half = 0; half < 2; ++half) { u32x4 ov[4], gv[4];
#pragma unroll
            for (int i = 0; i < 4; ++i) { const int ci = laneb + 64 * (4 * half + i), row = ci >> 4, ch = ci & 15; ov[i] = *(const lu4*)(ost + row * 256 + ch * 16); gv[i] = *(const u32x4*)(Gw + ((size_t)row * OP + ch * 8) * 2); }
#pragma unroll
            for (int i = 0; i < 4; ++i) { const int ci = laneb + 64 * (4 * half + i), row = ci >> 4, ch = ci & 15; u32x4 w;
#pragma unroll
                for (int e = 0; e < 4; ++e) { const float a0 = __uint_as_float(ov[i][e] << 16) * __uint_as_float(gv[i][e] << 16), a1 = __uint_as_float(ov[i][e] & 0xffff0000u) * __uint_as_float(gv[i][e] & 0xffff0000u); w[e] = cvtpk(a0, a1); }
                *(u32x4*)((char*)Ow + ((size_t)row * OP + ch * 8) * 2) = w; } }
    }
    if constexpr (F32) {
#pragma unroll
        for (int d0 = 0; d0 < 8; ++d0) S.qr[d0] = pack8(S.tq[2 * d0], S.tq[2 * d0 + 1]); }
    __syncthreads();
#undef RESC
#undef KBASE
#undef ACT
#undef MASKT
#undef SEAM_K0
#undef HALF_STEP
}
#undef ROW
#undef VMW
#undef VMWN
#undef SLOAD_H
#undef SWRITE_HK
#undef SWRITE_HV
#undef SWRITE_H
#undef SLOAD_F
#undef SWRITE_KF
#undef SWRITE_VF

__host__ __device__ inline int swa_nramp(int nqb, int W, int qoff) { const int t = W - 1 - qoff; const int n = t < 0 ? 0 : t / QB + 1; return n > nqb ? nqb : n; }
__host__ __device__ inline int swa_nx(int nqb, int nramp, int order) { return (order & ORDER_PAIRED) ? (nramp + 1) / 2 + (nqb - nramp) : nqb; }
struct SwaItem { int bh, qb0, qb1; };
__device__ __forceinline__ SwaItem swa_decode(int L, int nqb, int nx, int nramp) {
    SwaItem it; it.bh = L / nx; const int x = L - it.bh * nx; const int ns = nqb - nramp;
    if (x < ns) { it.qb0 = it.qb1 = nqb - 1 - x; } else { it.qb0 = x - ns; it.qb1 = nramp - 1 - it.qb0; }
    return it;
}
}
constexpr int NWAVES = 8;
#ifndef MK_N_LAUNCHES
#define MK_N_LAUNCHES 1
#endif
constexpr int DM = 2048, NBATCH = 4, SEQ = 4096, M = NBATCH * SEQ, DEPTH = 4, HD = 128, DH = 1024, EVEN_IN = 8192, ODD_IN = 8208, NFOX = 16, DFF = 5504, DFF2 = 2 * DFF;
constexpr int NUNITS = 64 * 64;
constexpr size_t MiB = 1u << 20;
constexpr size_t WS_CTL = 0, CTL_ZERO_BYTES = 1 * MiB;
constexpr size_t WS_RSP = 2 * MiB;
constexpr size_t WS_LF = 4 * MiB;
constexpr size_t WS_DEC = 5 * MiB;
constexpr size_t WS_WF = 7 * MiB;
constexpr size_t WS_WIE = 8 * MiB, WS_WOE = 72 * MiB, WS_WIO = 88 * MiB, WS_WOO = 152 * MiB, WS_WU = 168 * MiB, WS_WD = 340 * MiB;
constexpr size_t WS_XB = 426 * MiB;
constexpr size_t WS_OB = 490 * MiB;
constexpr size_t WS_PROJ = 554 * MiB;
constexpr size_t WS_KV = WS_PROJ + 256 * MiB;
constexpr size_t WS_ACT = 898 * MiB;
constexpr size_t WS_LOGF = 1070 * MiB;
constexpr size_t WS_ST = 1134 * MiB;
constexpr size_t WS_SB = 1262 * MiB;
constexpr size_t WS_END = 1274 * MiB;
static_assert(WS_WD + 4 * (size_t)DM * DFF * 2 <= WS_XB && WS_PROJ + (size_t)M * DFF2 * 2 <= WS_ACT && WS_KV + (size_t)NUNITS * 16384 * 4 <= WS_LOGF && WS_ACT + (size_t)M * DFF * 2 <= WS_LOGF, "ws map");
constexpr int CW_TMO = 0, CW_BAR = 4096, CW_NRM = 8192, CW_CONVQ = 9216  ;
constexpr int RING_BYTES = 131072, CS_OFF = fox::OST_OFF + fox::OST_BYTES  , CS_BYTES = 16384 + 64, MISC_OFF = CS_OFF + CS_BYTES, LDS_BYTES = MISC_OFF + 448;
static_assert(CS_OFF >= RING_BYTES, "lds map");
static_assert(LDS_BYTES <= 160 * 1024 && LDS_BYTES > 80 * 1024, "one workgroup per CU");

#define GAS __attribute__((address_space(1)))
#define LAS __attribute__((address_space(3)))
typedef unsigned short bf16;
typedef unsigned v4u __attribute__((ext_vector_type(4)));
typedef unsigned v2u __attribute__((ext_vector_type(2)));
typedef float f32x4 __attribute__((ext_vector_type(4)));
typedef float f32x2 __attribute__((ext_vector_type(2)));
typedef short bf16x8 __attribute__((ext_vector_type(8)));
#define LDS_WAIT() asm volatile("s_waitcnt lgkmcnt(0)" ::: "memory")
#define VM_WAIT() asm volatile("s_waitcnt vmcnt(0)" ::: "memory")
__device__ __forceinline__ unsigned f2bf(float f) { unsigned u = __builtin_bit_cast(unsigned, f); return (u + 0x7fffu + ((u >> 16) & 1u)) >> 16; }
__device__ __forceinline__ unsigned pk2(float lo, float hi) { return pg8::cvt_pk_bf16_c(lo, hi); }
__device__ __forceinline__ float bf2f(unsigned short b) { return __builtin_bit_cast(float, (unsigned)b << 16); }
__device__ __forceinline__ float bflo(unsigned w) { return __builtin_bit_cast(float, w << 16); }
__device__ __forceinline__ float bfhi(unsigned w) { return __builtin_bit_cast(float, w & 0xffff0000u); }
__device__ __forceinline__ float wave_sum(float v) {
    const int l_ = pg8::lane_now();
#pragma unroll
    for (int o = 1; o < 64; o <<= 1) v += pg8::shfl_xor_l(v, o, l_);
    return v;
}
#define XB_TMO      128
#define XB_XCNT(j)  (256  + 64 * (j))
#define XB_XSUB(j)  (1280 + 64 * (j))
#define XB_XGEN(j)  (2304 + 64 * (j))
#define XB_TOP      3328
#define XB_TOPGEN   3392
#define XCD_BAR_WORDS 3456
#define XB_SPIN_CAP (1u << 18)

__device__ __forceinline__ unsigned xb_ld(unsigned* p)              { return __hip_atomic_load(p, __ATOMIC_RELAXED, __HIP_MEMORY_SCOPE_AGENT); }
__device__ __forceinline__ unsigned xb_add(unsigned* p, unsigned v) { return __hip_atomic_fetch_add(p, v, __ATOMIC_RELAXED, __HIP_MEMORY_SCOPE_AGENT); }
__device__ __forceinline__ unsigned xb_xcc_id() { return (unsigned)__builtin_amdgcn_s_getreg((3 << 11) | 20) & 0xFu; }
#define XB_SPIN(cond, bar) do { unsigned _sp = 0; while (cond) { __builtin_amdgcn_s_sleep(1); \
    if ((++_sp & 255u) == 0u) { if (xb_ld(&(bar)[XB_TMO])) break; if (_sp > XB_SPIN_CAP) { atomicAdd(&(bar)[XB_TMO], 1u); break; } } } } while (0)

struct XcdBarrier {
    unsigned* bar; unsigned x;
    volatile LAS unsigned* st;
};

__device__ __forceinline__ XcdBarrier xcd_barrier_post(unsigned* bar, volatile LAS unsigned* st) {
    XcdBarrier b; b.bar = bar; b.x = xb_xcc_id(); b.st = st;
    if (threadIdx.x == 0) (void)xb_add(&bar[XB_XCNT(b.x)], 1u);
    return b;
}
__device__ __forceinline__ void xcd_barrier_complete(unsigned* bar, unsigned x, unsigned& nloc, unsigned& nx) {
    const unsigned G = gridDim.x * gridDim.y * gridDim.z;
    unsigned sum, cnt, mine, sp = 0u;
    for (;;) {
        sum = 0u; cnt = 0u; mine = 0u;
#pragma unroll
        for (unsigned j = 0; j < 16; ++j) { const unsigned c = xb_ld(&bar[XB_XCNT(j)]); sum += c; cnt += (c > 0u) ? 1u : 0u; mine = (j == x) ? c : mine; }
        if (sum == G) break;
        __builtin_amdgcn_s_sleep(1);
        if ((++sp & 255u) == 0u) { if (xb_ld(&bar[XB_TMO])) break; if (sp > XB_SPIN_CAP) { atomicAdd(&bar[XB_TMO], 1u); break; } }
    }
    nloc = mine > 0u ? mine : 1u; nx = cnt > 0u ? cnt : 1u;
}

__device__ __forceinline__ void xcd_barrier(const XcdBarrier& b) {
    asm volatile("s_waitcnt vmcnt(0)" ::: "memory");
    __syncthreads();
    if (threadIdx.x == 0) {
        unsigned* bar = b.bar;
        __builtin_amdgcn_s_waitcnt(0);
        unsigned nloc = b.st[0], nx = b.st[1];
        if (nloc == 0u) { xcd_barrier_complete(bar, b.x, nloc, nx); b.st[0] = nloc; b.st[1] = nx; }
        const unsigned old = xb_add(&bar[XB_XSUB(b.x)], 1u);
        const unsigned gen = old / nloc;
        if (old + 1u == (gen + 1u) * nloc) {
            __builtin_amdgcn_fence(__ATOMIC_RELEASE, "agent");
            asm volatile("s_waitcnt vmcnt(0)" ::: "memory");
            const unsigned og = xb_add(&bar[XB_TOP], 1u);
            const unsigned tg = og / nx;
            if (og + 1u == (tg + 1u) * nx) xb_add(&bar[XB_TOPGEN], 1u);
            else XB_SPIN(xb_ld(&bar[XB_TOPGEN]) == tg, bar);
            __builtin_amdgcn_fence(__ATOMIC_ACQUIRE, "agent");
            xb_add(&bar[XB_XGEN(b.x)], 1u);
            asm volatile("s_waitcnt vmcnt(0)" ::: "memory");
        } else {
            XB_SPIN(xb_ld(&bar[XB_XGEN(b.x)]) == gen, bar);
            __builtin_amdgcn_fence(__ATOMIC_ACQUIRE, "agent");
            asm volatile("s_waitcnt vmcnt(0)" ::: "memory");
        }
    }
    __syncthreads();
}
struct Ctx { LAS unsigned char* lds; int tid, lane, wave, vcu, G, bx; };

__device__ __forceinline__ int src_col(int n, int mode) {
    if (mode == 1 && (n >> 10) >= 4 && (n >> 10) <= 5) { const int p = n & 127; return (n & ~127) + (p >> 1) + 64 * (p & 1); }
    if (mode == 2) return ((n >> 7) & 1) * DFF + (n >> 8) * 128 + (n & 127);
    return n;
}
template <bool NT = false, int KB = 64>
__device__ __forceinline__ void transpose_item(const float* W, int ldw, int K, int N, const float* nw, int mode, bf16* WT, LAS float* scr, int item, int lane) {
    const int nblk = N / 32, kb = item / nblk, nb = item - kb * nblk, k0 = KB * kb, n0 = 32 * nb;
    const int sc = src_col(n0 + (lane & 31), mode);
    float wv[KB / 2];
#pragma unroll
    for (int i = 0; i < KB / 2; ++i) { const float* p_ = W + (size_t)(k0 + 2 * i + (lane >> 5)) * ldw + sc; wv[i] = NT ? __builtin_nontemporal_load(p_) : *p_; }
    if (nw) {
#pragma unroll
        for (int i = 0; i < KB / 2; ++i) wv[i] *= nw[k0 + 2 * i + (lane >> 5)]; }
#pragma unroll
    for (int i = 0; i < KB / 2; ++i) scr[(2 * i + (lane >> 5)) * 33 + (lane & 31)] = wv[i];
    LDS_WAIT(); asm volatile("" ::: "memory");
    const int c = lane & 7;
#pragma unroll
    for (int kk = 0; kk < KB / 64; ++kk)
#pragma unroll
        for (int j = 0; j < 4; ++j) { const int n = (lane >> 3) + 8 * j; const LAS float* s = scr + (64 * kk + 8 * c) * 33 + n;
            v4u o; o.x = pk2(s[0 * 33], s[1 * 33]); o.y = pk2(s[2 * 33], s[3 * 33]); o.z = pk2(s[4 * 33], s[5 * 33]); o.w = pk2(s[6 * 33], s[7 * 33]);
            bf16* dst = WT + (size_t)(n0 + n) * K + k0 + 64 * kk + 8 * c;
            if (NT) __builtin_nontemporal_store(o, (GAS v4u*)dst); else *(GAS v4u*)dst = o; }
    LDS_WAIT(); asm volatile("" ::: "memory");
}
__device__ __forceinline__ void p0_prologue(const Ctx& C, const float* const* in, unsigned char* ws, float* rs0) {
    LAS float* scr = (LAS float*)(C.lds + C.wave * 16384);
    const int gw = C.vcu * NWAVES + C.wave, NGW = C.G * NWAVES;
    int start = gw;
#define TR(Wp, ldw, K, N, nwp, mode, WTp) do { const int nit_ = ((K) / 64) * ((N) / 32); int it_ = start; for (; it_ < nit_; it_ += NGW) transpose_item(Wp, ldw, K, N, nwp, mode, WTp, scr, it_, C.lane); start = it_ - nit_; } while (0)
    TR(in[4], EVEN_IN, DM, EVEN_IN, in[1], 1, (bf16*)(ws + WS_WIE));
    TR(in[8], DM, DM, DM, (const float*)nullptr, 0, (bf16*)(ws + WS_WOE));
    for (int l = 0; l < 1; ++l) {
        TR(in[12] + (size_t)l * DM * DFF2, DFF2, DM, DFF2, in[2] + l * DM, 2, (bf16*)(ws + WS_WU) + (size_t)l * DFF2 * DM);
        TR(in[14] + (size_t)l * DFF * DM, DM, DFF, DM, (const float*)nullptr, 0, (bf16*)(ws + WS_WD) + (size_t)l * DM * DFF);
    }
#undef TR
    { bf16* WF = (bf16*)(ws + WS_WF);
      for (int i = C.vcu * 512 + C.tid; i < 2 * 16 * DM; i += C.G * 512) { const int j = i >> 15, o = (i >> 11) & 15, k = i & 2047;
          WF[i] = (bf16)f2bf(in[9][((size_t)j * DM + k) * ODD_IN + 8192 + o] * in[1][(2 * j + 1) * DM + k]); } }
    { const float* x = in[0]; bf16* XB = (bf16*)(ws + WS_XB);
      for (int m = gw; m < M; m += NGW) { const GAS f32x4* xr = (const GAS f32x4*)(x + (size_t)m * DM) + C.lane; GAS v2u* o8 = (GAS v2u*)(XB + (size_t)m * DM) + C.lane; float s = 0.f;
#pragma unroll
          for (int q = 0; q < 8; ++q) { const f32x4 v = xr[64 * q]; s += (v.x * v.x + v.y * v.y) + (v.z * v.z + v.w * v.w); v2u w; w.x = pk2(v.x, v.y); w.y = pk2(v.z, v.w); o8[64 * q] = w; }
          s = wave_sum(s); if (C.lane < 32) rs0[(size_t)m * 32 + C.lane] = C.lane == 0 ? s : 0.f; } }
}
__device__ __forceinline__ void prep_rstd(const Ctx& C, const float* rs, int pm0, LAS float* tab) {
    if (C.tid < 256) { const float* p = rs + ((size_t)pm0 * 256 + C.tid) * 32; float s = 0.f;
#pragma unroll
        for (int q = 0; q < 8; ++q) { const f32x4 v = *(const GAS f32x4*)(p + 4 * q); s += (v[0] + v[1]) + (v[2] + v[3]); }
        tab[C.tid] = __builtin_amdgcn_rsqf(s * (1.0f / (float)DM) + 1e-6f); }
    __syncthreads();
}
__device__ __forceinline__ void final_norm(const Ctx& C, const bf16* xb, float* out, const float* rs, const float* w) {
    const int gw = C.vcu * NWAVES + C.wave, NGW = C.G * NWAVES;
    for (int m = gw; m < M; m += NGW) { const GAS v2u* xr = (const GAS v2u*)(xb + (size_t)m * DM) + C.lane; GAS f32x4* orow = (GAS f32x4*)(out + (size_t)m * DM) + C.lane; const GAS f32x4* wr = (const GAS f32x4*)w + C.lane;
        const float rstd = __builtin_amdgcn_rsqf(wave_sum(C.lane < 32 ? rs[(size_t)m * 32 + C.lane] : 0.f) * (1.0f / (float)DM) + 1e-6f);
#pragma unroll
        for (int q = 0; q < 8; ++q) { const v2u x = xr[64 * q]; const f32x4 g = wr[64 * q]; orow[64 * q] = (f32x4){bflo(x.x) * rstd * g[0], bfhi(x.x) * rstd * g[1], bflo(x.y) * rstd * g[2], bfhi(x.y) * rstd * g[3]}; } }
}
__device__ __forceinline__ void flogit_phase(const Ctx& C, const bf16* xb, const bf16* wf, const float* rs, const float* bfv, float* lf) {
    const int fr = C.lane & 15, fq = C.lane >> 4;
    for (int tile = C.wave * C.G + C.vcu; tile < M / 16; tile += NWAVES * C.G) {
        const GAS bf16x8* ap = (const GAS bf16x8*)(xb + (size_t)(tile * 16 + fr) * DM + fq * 8); const GAS bf16x8* bp = (const GAS bf16x8*)(wf + (size_t)fr * DM + fq * 8);
        f32x4 acc = {0.f, 0.f, 0.f, 0.f};
#pragma unroll 8
        for (int ks = 0; ks < DM / 32; ++ks) acc = __builtin_amdgcn_mfma_f32_16x16x32_bf16(ap[ks * 4], bp[ks * 4], acc, 0, 0, 0);
        const float bias = bfv[fr];
#pragma unroll
        for (int r = 0; r < 4; ++r) { const int row = tile * 16 + 4 * fq + r; float ss = 0.f;
#pragma unroll
            for (int q = 0; q < 8; ++q) { const f32x4 p = *(const GAS f32x4*)(rs + (size_t)row * 32 + 4 * q); ss += (p[0] + p[1]) + (p[2] + p[3]); }
            const float v = acc[r] * __builtin_amdgcn_rsqf(ss * (1.0f / (float)DM) + 1e-6f) + bias;
            lf[(size_t)row * 16 + fr] = fminf(v, 0.f) - __logf(1.f + __expf(-fabsf(v))); }
    }
}
__device__ __forceinline__ void unpack8(const v4u w, float (&f)[8]) { f[0] = bflo(w.x); f[1] = bfhi(w.x); f[2] = bflo(w.y); f[3] = bfhi(w.y); f[4] = bflo(w.z); f[5] = bfhi(w.z); f[6] = bflo(w.w); f[7] = bfhi(w.w); }
__device__ __forceinline__ void conv_fix(const Ctx& C, const float* sb, const float* cw, bf16* ACT) {
    constexpr int NCG = DFF / 8;
    for (int it = C.vcu * 512 + C.tid; it < 63 * NCG; it += C.G * 512) {
        const int pmi = it / NCG + 1, cg = it - (pmi - 1) * NCG, c0 = cg * 8, pn = c0 >> 7, w = c0 & 127;
        if ((pmi & 15) == 0) continue;
        float ug[4][8], uv[4][8];
#pragma unroll
        for (int r = 0; r < 4; ++r) { const float* sp = sb + (size_t)(r < 2 ? (pmi - 1) * 4 + 2 + r : pmi * 4 + (r - 2)) * DFF2 + pn * 256 + w;
            const f32x4 a = *(const GAS f32x4*)sp, b = *(const GAS f32x4*)(sp + 4), c = *(const GAS f32x4*)(sp + 128), d = *(const GAS f32x4*)(sp + 132);
#pragma unroll
            for (int e = 0; e < 4; ++e) { ug[r][e] = a[e]; ug[r][4 + e] = b[e]; uv[r][e] = c[e]; uv[r][4 + e] = d[e]; } }
        float o0[8], o1[8];
#pragma unroll
        for (int e = 0; e < 8; ++e) { const float g0w = cw[c0 + e], g1w = cw[DFF2 + c0 + e], g2w = cw[2 * DFF2 + c0 + e], v0w = cw[DFF + c0 + e], v1w = cw[DFF2 + DFF + c0 + e], v2w = cw[2 * DFF2 + DFF + c0 + e];
            const float ga = g0w * ug[0][e] + g1w * ug[1][e] + g2w * ug[2][e], va = v0w * uv[0][e] + v1w * uv[1][e] + v2w * uv[2][e];
            const float gb = g0w * ug[1][e] + g1w * ug[2][e] + g2w * ug[3][e], vb = v0w * uv[1][e] + v1w * uv[2][e] + v2w * uv[3][e];
            o0[e] = ga * pg8::fsigmoid(ga) * va; o1[e] = gb * pg8::fsigmoid(gb) * vb; }
        *(GAS v4u*)(ACT + (size_t)(pmi * 256) * DFF + c0) = pg8::pack8f(o0); *(GAS v4u*)(ACT + (size_t)(pmi * 256 + 1) * DFF + c0) = pg8::pack8f(o1);
    }
}
#define LBAR() asm volatile("s_waitcnt lgkmcnt(0)\n\ts_barrier" ::: "memory")
__device__ __forceinline__ void tile_ld(v4u (&r)[2], const bf16* src, int tid) {
#pragma unroll
    for (int i = 0; i < 2; ++i) r[i] = *(const GAS v4u*)(src + (size_t)(tid + 512 * i) * 8);
}
__device__ __forceinline__ void tile_st(LAS unsigned char* dst, const v4u (&r)[2], int tid) {
#pragma unroll
    for (int i = 0; i < 2; ++i) { const int idx = tid + 512 * i; *(LAS v4u*)(dst + (idx >> 4) * 272 + (idx & 15) * 16) = r[i]; }
}
typedef _Float16 lf16;
__device__ __forceinline__ void lf_ld(unsigned (&lf)[16], const lf16* lft, int c, int sg) {
#pragma unroll
    for (int i = 0; i < 16; ++i) lf[i] = *(const GAS unsigned short*)((const unsigned short*)lft + (16 * sg + i) * 128 + c);
}
__device__ __forceinline__ float lf_cv(unsigned w) { return (float)__builtin_bit_cast(lf16, (unsigned short)w); }
__device__ __forceinline__ void chunk_cumsum(float (&b)[16], float& blast, float& bmid, LAS float* segsum, int c, int sg) {
#pragma unroll
    for (int i = 1; i < 16; ++i) b[i] += b[i - 1];
    segsum[sg * 128 + c] = b[15];
    LBAR();
    const float s0 = segsum[c], s1 = segsum[128 + c], s2 = segsum[256 + c], s3 = segsum[384 + c];
    const float off = sg == 0 ? 0.f : (sg == 1 ? s0 : (sg == 2 ? s0 + s1 : s0 + s1 + s2));
#pragma unroll
    for (int i = 0; i < 16; ++i) b[i] += off;
    bmid = s0 + s1; blast = (s0 + s1) + (s2 + s3);
}
#define LFRAG(base, pitch, row, kk) (*(const LAS bf16x8*)((base) + (row) * (pitch) + (kk) * 2))
struct EUnit { int ret, h, hh; size_t m0, hoff; };
__device__ __forceinline__ EUnit e_unit(int unit) { EUnit u; const int chain = unit >> 6, n = unit & 63, b = chain >> 4; u.hh = chain & 15; u.ret = u.hh >> 3; u.h = u.hh & 7; u.m0 = (size_t)b * SEQ + n * 64; u.hoff = ((size_t)u.h * M + u.m0) * 128; return u; }
__device__ __forceinline__ void even_ea(const Ctx& C, const bf16* proj, const lf16* logf, float* SUMKV, float* SUMD) {
    LAS unsigned char* L = C.lds;
    constexpr int O_KRAW = 0, O_VRAW = 17408, O_KT = 34816, O_VT = 53248, O_SS = 71680, O_DEC = 73728;
    const int c = C.tid & 127, sg = C.tid >> 7, fr = C.lane & 15, fq = C.lane >> 4;
    for (int cq = C.vcu; cq < 256; cq += C.G) {
        const int unit0 = (cq >> 2) * 64 + (cq & 3) * 16;
        f32x4 acc[8];
#pragma unroll
        for (int tn = 0; tn < 8; ++tn) acc[tn] = (f32x4){0.f, 0.f, 0.f, 0.f};
        float bltot = 0.f;
        v4u rk[2], rv[2]; unsigned lf[16];
        { const EUnit u = e_unit(unit0); if (u.ret) tile_ld(rk, proj + (size_t)5 * M * 1024 + u.hoff, C.tid); tile_ld(rv, proj + (size_t)(u.ret ? 6 : 2) * M * 1024 + u.hoff, C.tid); if (!u.ret) lf_ld(lf, logf + u.hoff, c, sg); }
#pragma unroll 1
        for (int i = 0; i < 16; ++i) {
            const EUnit u = e_unit(unit0 + i);
            if (u.ret) tile_st(L + O_KRAW, rk, C.tid);
            tile_st(L + O_VRAW, rv, C.tid);
            float bc[16], blast, bmid; const float lg = log1pf(-exp2f(-5.f - (float)u.h));
#pragma unroll
            for (int q = 0; q < 16; ++q) bc[q] = u.ret ? lg : lf_cv(lf[q]);
            float kk[16];
#pragma unroll
            for (int q = 0; q < 16; ++q) kk[q] = u.ret ? 0.f : 1.f - __expf(bc[q]);
            if (i + 1 < 16) { const EUnit v = e_unit(unit0 + i + 1); if (v.ret) tile_ld(rk, proj + (size_t)5 * M * 1024 + v.hoff, C.tid); tile_ld(rv, proj + (size_t)(v.ret ? 6 : 2) * M * 1024 + v.hoff, C.tid); if (!v.ret) lf_ld(lf, logf + v.hoff, c, sg); }
            chunk_cumsum(bc, blast, bmid, (LAS float*)(L + O_SS), c, sg);
            unsigned kw[8], vw[8];
#pragma unroll
            for (int q = 0; q < 8; ++q) { const int t0 = 16 * sg + 2 * q;
                float k0 = kk[2 * q], k1 = kk[2 * q + 1];
                if (u.ret) { k0 = bf2f(*(const LAS unsigned short*)(L + O_KRAW + t0 * 272 + c * 2)); k1 = bf2f(*(const LAS unsigned short*)(L + O_KRAW + (t0 + 1) * 272 + c * 2)); }
                const unsigned short v0 = *(const LAS unsigned short*)(L + O_VRAW + t0 * 272 + c * 2), v1 = *(const LAS unsigned short*)(L + O_VRAW + (t0 + 1) * 272 + c * 2);
                kw[q] = pk2(k0 * __expf(fmaxf(blast - bc[2 * q], -80.f)), k1 * __expf(fmaxf(blast - bc[2 * q + 1], -80.f)));
                vw[q] = (unsigned)v0 | ((unsigned)v1 << 16); }
            *(LAS v4u*)(L + O_KT + c * 144 + sg * 32) = (v4u){kw[0], kw[1], kw[2], kw[3]}; *(LAS v4u*)(L + O_KT + c * 144 + sg * 32 + 16) = (v4u){kw[4], kw[5], kw[6], kw[7]};
            *(LAS v4u*)(L + O_VT + c * 144 + sg * 32) = (v4u){vw[0], vw[1], vw[2], vw[3]}; *(LAS v4u*)(L + O_VT + c * 144 + sg * 32 + 16) = (v4u){vw[4], vw[5], vw[6], vw[7]};
            if (sg == 0) ((LAS float*)(L + O_DEC))[c] = __expf(fmaxf(blast, -80.f));
            bltot += blast;
            LBAR();
            const f32x4 dec4 = *(const LAS f32x4*)(L + O_DEC + (16 * C.wave + 4 * fq) * 4);
#pragma unroll
            for (int tn = 0; tn < 8; ++tn) acc[tn] = acc[tn] * dec4;
#pragma unroll
            for (int ks = 0; ks < 2; ++ks) { const bf16x8 a = LFRAG(L + O_KT, 144, 16 * C.wave + fr, 32 * ks + 8 * fq);
#pragma unroll
                for (int tn = 0; tn < 8; ++tn) acc[tn] = __builtin_amdgcn_mfma_f32_16x16x32_bf16(a, LFRAG(L + O_VT, 144, 16 * tn + fr, 32 * ks + 8 * fq), acc[tn], 0, 0, 0); }
            LBAR();
        }
        float* kvp = SUMKV + (size_t)cq * 16384 + 16 * C.wave + 4 * fq;
#pragma unroll
        for (int tn = 0; tn < 8; ++tn) *(GAS f32x4*)(kvp + (16 * tn + fr) * 128) = acc[tn];
        if (sg == 0) SUMD[(size_t)cq * 128 + c] = __expf(fmaxf(bltot, -80.f));
    }
}
template <int VAR>
__device__ __forceinline__ void even_eb(const Ctx& C, const bf16* proj, const lf16* logf, const float* SUMKV, const float* SUMD, const float* nw_h, const float* nw_r, bf16* OB) {
    LAS unsigned char* L = C.lds;
    constexpr int O_Q = 0, O_K = 17408, O_QH = 34816, O_VRAW = 52224, O_VT = 69632, O_ST = 88064, O_SS = 122880, O_DEC = 124928, O_KT = 125440, O_P = O_VRAW, O_OB = 0;
    static_assert(O_KT + 128 * 144 <= CS_OFF + CS_BYTES, "lds map (EB)");
    const int c = C.tid & 127, sg = C.tid >> 7;
    for (int cq = C.vcu; cq < 256; cq += C.G) {
        const int chain = cq >> 2, qd = cq & 3, unit0 = chain * 64 + qd * 16;
        int fr = C.lane & 15, fq = C.lane >> 4;
        f32x4 S[8];
#pragma unroll
        for (int tn = 0; tn < 8; ++tn) S[tn] = (f32x4){0.f, 0.f, 0.f, 0.f};
        for (int qp = 0; qp < qd; ++qp) { const size_t cp = (size_t)(chain * 4 + qp);
            const f32x4 d4 = *(const GAS f32x4*)(SUMD + cp * 128 + 16 * C.wave + 4 * fq);
#pragma unroll
            for (int tn = 0; tn < 8; ++tn) S[tn] = S[tn] * d4 + *(const GAS f32x4*)(SUMKV + cp * 16384 + (16 * tn + fr) * 128 + 16 * C.wave + 4 * fq); }
#pragma unroll
        for (int tn = 0; tn < 8; ++tn) *(LAS v2u*)(L + O_ST + (16 * tn + fr) * 272 + (16 * C.wave + 4 * fq) * 2) = (v2u){pk2(S[tn][0], S[tn][1]), pk2(S[tn][2], S[tn][3])};
        f32x4 nwv[4];
        { const EUnit u0 = e_unit(unit0); const float* nw = (u0.ret ? nw_r : nw_h) + u0.h * 128 + (C.tid & 7) * 16;
#pragma unroll
          for (int q4 = 0; q4 < 4; ++q4) nwv[q4] = *(const GAS f32x4*)(nw + 4 * q4); }
        v4u rq[2][2], rk[2][2], rv[2][2], rg[2][2]; unsigned lf[2][16];
        auto pref = [&](v4u (&q_)[2], v4u (&k_)[2], v4u (&v_)[2], v4u (&g_)[2], unsigned (&lf_)[16], const int un) __attribute__((always_inline)) {
            const EUnit w_ = e_unit(un); tile_ld(q_, proj + (size_t)(w_.ret ? 4 : 0) * M * 1024 + w_.hoff, C.tid); if (w_.ret) tile_ld(k_, proj + (size_t)5 * M * 1024 + w_.hoff, C.tid);
            tile_ld(v_, proj + (size_t)(w_.ret ? 6 : 2) * M * 1024 + w_.hoff, C.tid);
            { const bf16* gp_ = proj + (size_t)(w_.ret ? 7 : 3) * M * 1024 + w_.hoff + (size_t)C.tid * 16; g_[0] = *(const GAS v4u*)gp_; g_[1] = *(const GAS v4u*)(gp_ + 8); }
            if (!w_.ret) lf_ld(lf_, logf + w_.hoff, c, sg); };
        pref(rq[0], rk[0], rv[0], rg[0], lf[0], unit0); pref(rq[1], rk[1], rv[1], rg[1], lf[1], unit0 + 1);
        auto chunk = [&](v4u (&q_)[2], v4u (&k_)[2], v4u (&v_)[2], v4u (&g_)[2], unsigned (&lf_)[16], const int i) __attribute__((always_inline)) {
            const int unit = unit0 + i;
            { int l_ = C.lane; asm volatile("" : "+v"(l_)); fr = l_ & 15; fq = l_ >> 4; }
            const EUnit u = e_unit(unit); const int ret = u.ret, h = u.h, hh = u.hh; const size_t m0 = u.m0;
            tile_st(L + O_Q, q_, C.tid); if (ret) tile_st(L + O_K, k_, C.tid);
            tile_st(L + O_VRAW, v_, C.tid);
            const v4u gp0 = g_[0], gp1 = g_[1];
            float bc[16], blast, bmid; const float lg = log1pf(-exp2f(-5.f - (float)h));
#pragma unroll
            for (int q = 0; q < 16; ++q) bc[q] = ret ? lg : lf_cv(lf_[q]);
            float kk[16];
#pragma unroll
            for (int q = 0; q < 16; ++q) kk[q] = ret ? 0.f : 1.f - __expf(bc[q]);
            if (i + 2 < 16 && !(VAR & 16)) pref(q_, k_, v_, g_, lf_, unit + 2);
            chunk_cumsum(bc, blast, bmid, (LAS float*)(L + O_SS), c, __builtin_amdgcn_readfirstlane(sg));
            unsigned vw[8], kw[8];
            int a0 = 16 * sg * 272 + c * 2; asm volatile("" : "+v"(a0));
            if (!(VAR & 1)) {
            constexpr float L2E = 1.44269504f, CL2 = 115.4f;
            const float bm2 = bmid * L2E;
            const f32x2 E12 = {__builtin_amdgcn_exp2f(fmaxf(bm2, -CL2)), __builtin_amdgcn_exp2f(fmaxf(blast * L2E - bm2, -CL2))};
#pragma unroll
            for (int q8 = 0; q8 < 8; ++q8) { f32x2 sq[2], sh[2];
#pragma unroll
                for (int z = 0; z < 2; ++z) {
                    const float e2 = __builtin_amdgcn_fmed3f(__builtin_fmaf(bc[2 * q8 + z], L2E, -bm2), -CL2, CL2);
                    const float ee = __builtin_amdgcn_exp2f(e2), ei = __builtin_amdgcn_rcpf(ee);
                    float kr_ = kk[2 * q8 + z]; if (ret) kr_ = bf2f(*(const LAS unsigned short*)(L + O_K + a0 + (2 * q8 + z) * 272));
                    const f32x2 qk = {bf2f(*(const LAS unsigned short*)(L + O_Q + a0 + (2 * q8 + z) * 272)), kr_};
                    sq[z] = qk * (f32x2){ee, ei}; sh[z] = sq[z] * E12; }
                const unsigned wq = pk2(sq[0].x, sq[1].x), wk = pk2(sq[0].y, sq[1].y), wh = pk2(sh[0].x, sh[1].x);
                kw[q8] = pk2(sh[0].y, sh[1].y);
                *(LAS unsigned short*)(L + O_Q + a0 + (2 * q8) * 272) = (unsigned short)wq; *(LAS unsigned short*)(L + O_Q + a0 + (2 * q8 + 1) * 272) = (unsigned short)(wq >> 16);
                *(LAS unsigned short*)(L + O_K + a0 + (2 * q8) * 272) = (unsigned short)wk; *(LAS unsigned short*)(L + O_K + a0 + (2 * q8 + 1) * 272) = (unsigned short)(wk >> 16);
                *(LAS unsigned short*)(L + O_QH + a0 + (2 * q8) * 272) = (unsigned short)wh; *(LAS unsigned short*)(L + O_QH + a0 + (2 * q8 + 1) * 272) = (unsigned short)(wh >> 16);
                const unsigned short v0 = *(const LAS unsigned short*)(L + O_VRAW + a0 + (2 * q8) * 272), v1 = *(const LAS unsigned short*)(L + O_VRAW + a0 + (2 * q8 + 1) * 272);
                vw[q8] = (unsigned)v0 | ((unsigned)v1 << 16); }
            *(LAS v4u*)(L + O_VT + c * 144 + sg * 32) = (v4u){vw[0], vw[1], vw[2], vw[3]}; *(LAS v4u*)(L + O_VT + c * 144 + sg * 32 + 16) = (v4u){vw[4], vw[5], vw[6], vw[7]};
            *(LAS v4u*)(L + O_KT + c * 144 + sg * 32) = (v4u){kw[0], kw[1], kw[2], kw[3]}; *(LAS v4u*)(L + O_KT + c * 144 + sg * 32 + 16) = (v4u){kw[4], kw[5], kw[6], kw[7]};
            if (sg == 0) ((LAS float*)(L + O_DEC))[c] = __expf(fmaxf(blast, -80.f));
            }
            LBAR();
            if (!(VAR & 2)) {
            const int tm = C.wave >> 1, t = 16 * tm + fr;
#pragma unroll
            for (int tt = 0; tt < 2; ++tt) { const int tn = 2 * (C.wave & 1) + tt; f32x4 acc = {0.f, 0.f, 0.f, 0.f};
                if (tn <= tm) {
#pragma unroll
                    for (int ks = 0; ks < 4; ++ks) acc = __builtin_amdgcn_mfma_f32_16x16x32_bf16(LFRAG(L + O_K, 272, 16 * tn + fr, 32 * ks + 8 * fq), LFRAG(L + O_Q, 272, t, 32 * ks + 8 * fq), acc, 0, 0, 0); }
                const int s0 = 16 * tn + 4 * fq;
#pragma unroll
                for (int r = 0; r < 4; ++r) if (s0 + r > t) acc[r] = 0.f;
                *(LAS v2u*)(L + O_P + t * 144 + s0 * 2) = (v2u){pk2(acc[0], acc[1]), pk2(acc[2], acc[3])}; }
            LBAR();
            f32x4 o[4]; const int tn0 = 4 * (C.wave & 1);
#pragma unroll
            for (int j = 0; j < 4; ++j) o[j] = (f32x4){0.f, 0.f, 0.f, 0.f};
#pragma unroll
            for (int ks = 0; ks < 2; ++ks) { const bf16x8 a = LFRAG(L + O_P, 144, t, 32 * ks + 8 * fq);
#pragma unroll
                for (int j = 0; j < 4; ++j) o[j] = __builtin_amdgcn_mfma_f32_16x16x32_bf16(LFRAG(L + O_VT, 144, 16 * (tn0 + j) + fr, 32 * ks + 8 * fq), a, o[j], 0, 0, 0); }
#pragma unroll
            for (int ks = 0; ks < 4; ++ks) { const bf16x8 a = LFRAG(L + O_QH, 272, t, 32 * ks + 8 * fq);
#pragma unroll
                for (int j = 0; j < 4; ++j) o[j] = __builtin_amdgcn_mfma_f32_16x16x32_bf16(LFRAG(L + O_ST, 272, 16 * (tn0 + j) + fr, 32 * ks + 8 * fq), a, o[j], 0, 0, 0); }
#pragma unroll
            for (int j = 0; j < 4; ++j) *(LAS f32x4*)(L + O_OB + t * 528 + (16 * (tn0 + j) + 4 * fq) * 4) = o[j];
            LBAR();
            } else { LBAR(); LBAR(); }
            if (!(VAR & 4))
            { const int row = C.tid >> 3, cg = C.tid & 7, ln_ = pg8::lane_now(); f32x2 x2[8];
#pragma unroll
              for (int q4 = 0; q4 < 4; ++q4) { const f32x4 v = *(const LAS f32x4*)(L + O_OB + row * 528 + cg * 64 + q4 * 16); x2[2 * q4] = (f32x2){v[0], v[1]}; x2[2 * q4 + 1] = (f32x2){v[2], v[3]}; }
              float mean = 0.f;
              if (ret) { f32x2 s2 = x2[0];
#pragma unroll
                  for (int e = 1; e < 8; ++e) s2 += x2[e];
                  float s = s2.x + s2.y; s += pg8::shfl_xor_l(s, 1, ln_); s += pg8::shfl_xor_l(s, 2, ln_); s += pg8::shfl_xor_l(s, 4, ln_); mean = s * (1.f / 128.f); }
              const f32x2 m2 = {mean, mean}; f32x2 ss2 = {0.f, 0.f};
#pragma unroll
              for (int e = 0; e < 8; ++e) { x2[e] -= m2; ss2 += x2[e] * x2[e]; }
              float ss = ss2.x + ss2.y; ss += pg8::shfl_xor_l(ss, 1, ln_); ss += pg8::shfl_xor_l(ss, 2, ln_); ss += pg8::shfl_xor_l(ss, 4, ln_);
              const float rstd = __builtin_amdgcn_rsqf(ss * (1.f / 128.f) + 1e-6f); const f32x2 r2 = {rstd, rstd};
              const unsigned gw[8] = {gp0.x, gp0.y, gp0.z, gp0.w, gp1.x, gp1.y, gp1.z, gp1.w};
              unsigned yw[8];
#pragma unroll
              for (int q4 = 0; q4 < 4; ++q4) { const f32x4 w = nwv[q4];
#pragma unroll
                  for (int e = 0; e < 2; ++e) { const f32x2 y = x2[2 * q4 + e] * r2 * (f32x2){w[2 * e], w[2 * e + 1]} * (f32x2){bflo(gw[2 * q4 + e]), bfhi(gw[2 * q4 + e])}; yw[2 * q4 + e] = pk2(y.x, y.y); } }
              bf16* op = OB + (m0 + row) * DM + hh * 128 + cg * 16;
              *(GAS v4u*)op = (v4u){yw[0], yw[1], yw[2], yw[3]}; *(GAS v4u*)(op + 8) = (v4u){yw[4], yw[5], yw[6], yw[7]}; }
            if (!(VAR & 8))
            { const f32x4 dec4 = *(const LAS f32x4*)(L + O_DEC + (16 * C.wave + 4 * fq) * 4);
#pragma unroll
              for (int tn = 0; tn < 8; ++tn) S[tn] = S[tn] * dec4;
#pragma unroll
              for (int ks = 0; ks < 2; ++ks) { const bf16x8 a = LFRAG(L + O_KT, 144, 16 * C.wave + fr, 32 * ks + 8 * fq);
#pragma unroll
                  for (int tn = 0; tn < 8; ++tn) S[tn] = __builtin_amdgcn_mfma_f32_16x16x32_bf16(a, LFRAG(L + O_VT, 144, 16 * tn + fr, 32 * ks + 8 * fq), S[tn], 0, 0, 0); }
#pragma unroll
              for (int tn = 0; tn < 8; ++tn) *(LAS v2u*)(L + O_ST + (16 * tn + fr) * 272 + (16 * C.wave + 4 * fq) * 2) = (v2u){pk2(S[tn][0], S[tn][1]), pk2(S[tn][2], S[tn][3])}; }
            LBAR();
        };
#pragma unroll 1
        for (int i = 0; i < 16; i += 2) { chunk(rq[0], rk[0], rv[0], rg[0], lf[0], i); chunk(rq[1], rk[1], rv[1], rg[1], lf[1], i + 1); }
    }
}
__device__ __forceinline__ void fox_cs(const float* lf, int bh, LAS float* cs, int tid, int lane, int wave) {
    { int t_ = threadIdx.x; asm volatile("" : "+v"(t_)); tid = t_; lane = t_ & 63; wave = __builtin_amdgcn_readfirstlane(t_ >> 6); }
    const int b = bh >> 4, h = bh & 15; const float* base = lf + ((size_t)b * SEQ + tid * 8) * 16 + h; float v[8];
#pragma unroll
    for (int e = 0; e < 8; ++e) v[e] = base[e * 16];
#pragma unroll
    for (int e = 1; e < 8; ++e) v[e] += v[e - 1];
    float x = v[7];
#pragma unroll
    for (int d = 1; d < 64; d <<= 1) { const float y = pg8::shfl_up_l(x, d, lane); if (lane >= d) x += y; }
    if (lane == 63) cs[4096 + wave] = x;
    __syncthreads();
    float off = x - v[7];
    for (int w = 0; w < wave; ++w) off += cs[4096 + w];
#pragma unroll
    for (int e = 0; e < 8; ++e) cs[tid * 8 + e] = (v[e] + off) * -11.313708498984761f;
    __syncthreads();
}
constexpr int CF_KB = 128;
constexpr int CF_IE = (DM / CF_KB) * (EVEN_IN / 32), CF_OO = (DM / CF_KB) * (DM / 32), CF_U = (DM / CF_KB) * (DFF2 / 32), CF_D = (DFF / CF_KB) * (DM / 32);
static_assert(DM % CF_KB == 0 && DFF % CF_KB == 0, "filler item height");
static_assert(CF_IE % 8 == 0 && CF_OO % 8 == 0 && CF_U % 8 == 0 && CF_D % 8 == 0, "eight wave items per claim never straddle two matrices");
__device__ __forceinline__ constexpr int cf_items(int set) { return set == 0 ? CF_IE + CF_D : set == 1 ? CF_OO : set == 2 ? CF_IE + CF_OO + CF_U + CF_D : set == 3 ? CF_IE + CF_OO + CF_U : CF_U + CF_D; }
__device__ __forceinline__ void conv_mat(int mat, int i, int r, const float* const* in, unsigned char* ws, LAS float* scr, int lane) {
    if (mat == 0) transpose_item<true, CF_KB>(in[4] + (size_t)i * DM * EVEN_IN, EVEN_IN, DM, EVEN_IN, in[1] + (2 * i) * DM, 1, (bf16*)(ws + WS_WIE) + (size_t)i * EVEN_IN * DM, scr, r, lane);
    else if (mat == 1) transpose_item<true, CF_KB>(in[8] + (size_t)i * DM * DM, DM, DM, DM, (const float*)nullptr, 0, (bf16*)(ws + WS_WOE) + (size_t)i * DM * DM, scr, r, lane);
    else if (mat == 2) transpose_item<true, CF_KB>(in[9] + (size_t)i * DM * ODD_IN, ODD_IN, DM, 8192, in[1] + (2 * i + 1) * DM, 0, (bf16*)(ws + WS_WIO) + (size_t)i * 8192 * DM, scr, r, lane);
    else if (mat == 3) transpose_item<true, CF_KB>(in[11] + (size_t)i * DM * DM, DM, DM, DM, (const float*)nullptr, 0, (bf16*)(ws + WS_WOO) + (size_t)i * DM * DM, scr, r, lane);
    else if (mat == 4) transpose_item<true, CF_KB>(in[12] + (size_t)i * DM * DFF2, DFF2, DM, DFF2, in[2] + i * DM, 2, (bf16*)(ws + WS_WU) + (size_t)i * DFF2 * DM, scr, r, lane);
    else transpose_item<true, CF_KB>(in[14] + (size_t)i * DFF * DM, DM, DFF, DM, (const float*)nullptr, 0, (bf16*)(ws + WS_WD) + (size_t)i * DM * DFF, scr, r, lane);
}
__device__ __forceinline__ void conv_item(int set, int r, const float* const* in, unsigned char* ws, LAS float* scr, int lane) {
    if (set == 0) {
        if (r < CF_IE) { conv_mat(2, 1, r, in, ws, scr, lane); return; } r -= CF_IE;
        conv_mat(5, 2, r, in, ws, scr, lane);
    } else if (set == 1) {
        conv_mat(3, 1, r, in, ws, scr, lane);
    } else if (set == 2) {
        if (r < CF_IE) { conv_mat(2, 0, r, in, ws, scr, lane); return; } r -= CF_IE;
        if (r < CF_OO) { conv_mat(3, 0, r, in, ws, scr, lane); return; } r -= CF_OO;
        if (r < CF_U) { conv_mat(4, 1, r, in, ws, scr, lane); return; } r -= CF_U;
        conv_mat(5, 1, r, in, ws, scr, lane);
    } else if (set == 3) {
        if (r < CF_IE) { conv_mat(0, 1, r, in, ws, scr, lane); return; } r -= CF_IE;
        if (r < CF_OO) { conv_mat(1, 1, r, in, ws, scr, lane); return; } r -= CF_OO;
        conv_mat(4, 2, r, in, ws, scr, lane);
    } else {
        if (r < CF_U) { conv_mat(4, 3, r, in, ws, scr, lane); return; } r -= CF_U;
        conv_mat(5, 3, r, in, ws, scr, lane); }
}
__device__ __forceinline__ void conv_filler(int set, const float* const* in, unsigned char* ws, unsigned* queue, LAS unsigned char* ldsb) {
    int t_ = threadIdx.x; asm volatile("" : "+v"(t_)); const int lane = t_ & 63, wave = __builtin_amdgcn_readfirstlane(t_ >> 6);
    const int nclaims = cf_items(set) / 8;
    volatile LAS int* qw = (volatile LAS int*)(ldsb + CS_OFF + 16384 + 32);
    LAS float* scr = (LAS float*)(ldsb + wave * 17408);
    __syncthreads();
    if (t_ == 0) qw[0] = (int)atomicAdd(queue, 1u);
    __syncthreads();
    int cl = qw[0];
    while (cl < nclaims) {
        unsigned nxt = 0u; if (t_ == 0) nxt = atomicAdd(queue, 1u);
        conv_item(set, cl * 8 + wave, in, ws, scr, lane);
        __syncthreads();
        if (t_ == 0) qw[0] = (int)nxt;
        __syncthreads();
        cl = qw[0];
    }
}
typedef fox::BlockRef<__hip_bfloat16, __hip_bfloat16> FoxRef;
__device__ __forceinline__ FoxRef fox_ref(const fox::SwaItem& it, int pass, const bf16* QH, const bf16* KH, const bf16* VH, bf16* OB) {
    const int qb = pass ? it.qb1 : it.qb0, b = it.bh >> 4, hh = it.bh & 15; FoxRef r; r.thr = 0.f;
    r.Q = (const __hip_bfloat16*)(QH + ((size_t)it.bh * SEQ + (size_t)qb * 256) * 128); r.K = (const __hip_bfloat16*)(KH + (size_t)it.bh * SEQ * 128); r.V = (const __hip_bfloat16*)(VH + (size_t)it.bh * SEQ * 128);
    const size_t oo = ((size_t)b * SEQ + (size_t)qb * 256) * DM + hh * 128; r.O = (__hip_bfloat16*)(OB + oo); r.P0 = qb * 256;
    return r;
}
__device__ __forceinline__ float fox_dmin(const bf16* Qb, const bf16* Kb, LAS float* red) {
    int t_ = threadIdx.x; asm volatile("" : "+v"(t_));
    const int row = t_ >> 1, hf = t_ & 1; const GAS v4u* qp = (const GAS v4u*)(Qb + (size_t)row * 128 + hf * 64); const GAS v4u* kp = (const GAS v4u*)(Kb + (size_t)row * 128 + hf * 64);
    v4u q8[8], k8[8];
#pragma unroll
    for (int i = 0; i < 8; ++i) { q8[i] = qp[i]; k8[i] = kp[i]; }
    float d = 0.f;
#pragma unroll
    for (int i = 0; i < 8; ++i) {
#pragma unroll
        for (int e = 0; e < 4; ++e) { d = __builtin_fmaf(bflo(q8[i][e]), bflo(k8[i][e]), d); d = __builtin_fmaf(bfhi(q8[i][e]), bfhi(k8[i][e]), d); } }
    const int ln_ = t_ & 63;
    d += pg8::shfl_xor_l(d, 1, ln_);
#pragma unroll
    for (int o = 2; o < 64; o <<= 1) d = fminf(d, pg8::shfl_xor_l(d, o, ln_));
    __syncthreads();
    if ((t_ & 63) == 0) red[t_ >> 6] = d;
    __syncthreads();
    float m = red[0];
#pragma unroll
    for (int w = 1; w < 8; ++w) m = fminf(m, red[w]);
    return m * 0.08838834764831845f;
}
__device__ __forceinline__ void fox_phase(const Ctx& C, char* lds, const bf16* QH, const bf16* KH, const bf16* VH, const bf16* G, bf16* OB, const float* LF, const unsigned* nrm, const float* bfv) {
    constexpr int nqb = SEQ / 256;
    LAS float* cs = (LAS float*)(C.lds + CS_OFF); const long gdelta = (const char*)G - (const char*)OB;
    int rank = 0;
    { const int my = C.lane & 15; const float bv = bfv[my];
      for (int o = 0; o < 16; ++o) { const float ov = bfv[o]; rank += (ov < bv || (ov == bv && o < my)) ? 1 : 0; } }
    for (int grp = C.vcu; grp < NBATCH * 64; grp += C.G) {
        const int b = grp >> 6, pr = (grp >> 3) & 7, x = grp & 7;
#pragma unroll 1
        for (int half = 0; half < 2; ++half) {
            const int want = half ? pr : 15 - pr;
            const int hh = __builtin_amdgcn_readfirstlane(__builtin_ctzll(__ballot(rank == want && C.lane < 16)));
            fox::SwaItem it; it.bh = b * 16 + hh; it.qb0 = x; it.qb1 = nqb - 1 - x;
            if (half) __syncthreads();
            fox_cs(LF, it.bh, cs, C.tid, C.lane, C.wave);
            float bqk;
            { const unsigned* nq = nrm + (size_t)it.bh * 4; const unsigned* nk = nrm + (size_t)(64 + it.bh) * 4;
              const float q2 = (__uint_as_float(nq[0]) + __uint_as_float(nq[1])) + (__uint_as_float(nq[2]) + __uint_as_float(nq[3])), k2 = (__uint_as_float(nk[0]) + __uint_as_float(nk[1])) + (__uint_as_float(nk[2]) + __uint_as_float(nk[3]));
              bqk = 1.02f * 0.08838834764831845f * sqrtf(q2 * k2); }
            FoxRef r0 = fox_ref(it, 0, QH, KH, VH, OB), r1 = fox_ref(it, 1, QH, KH, VH, OB);
            { const float d0 = fox_dmin((const bf16*)r0.Q, (const bf16*)r0.K + (size_t)r0.P0 * 128, cs + 4104), d1 = fox_dmin((const bf16*)r1.Q, (const bf16*)r1.K + (size_t)r1.P0 * 128, cs + 4104);
              r0.thr = (26.02f + bqk - fminf(d0, bqk)) * 11.313708498984761f; r1.thr = (26.02f + bqk - fminf(d1, bqk)) * 11.313708498984761f; }
            fox::Seam<__hip_bfloat16> S;
            fox::causal_swa_prime<__hip_bfloat16, __hip_bfloat16>(r0, SEQ, lds, S, cs);
            fox::causal_swa_block<__hip_bfloat16, __hip_bfloat16>(r0, r1, SEQ, SEQ, lds, S, cs, gdelta);
            fox::causal_swa_block<__hip_bfloat16, __hip_bfloat16>(r1, r1, SEQ, SEQ, lds, S, cs, gdelta);
        }
    }
}
constexpr int N_PHASES = 28;
struct Args { const float* in[15]; float* out; unsigned char* ws; int ph_lo, ph_hi; };
__global__ void __launch_bounds__(NWAVES * 64, 2) mk_fwd(Args args) {
    extern __shared__ __attribute__((aligned(16))) unsigned char lds[];
    { volatile LAS unsigned* MISC0 = (volatile LAS unsigned*)((LAS unsigned char*)lds + MISC_OFF); if (threadIdx.x < 112) MISC0[threadIdx.x] = 0u; }
    __syncthreads();
    XcdBarrier bar; bar.bar = (unsigned*)(args.ws + WS_CTL) + CW_BAR; bar.x = 0; bar.st = nullptr;
    if (MK_N_LAUNCHES == 1) bar = xcd_barrier_post((unsigned*)(args.ws + WS_CTL) + CW_BAR, (volatile LAS unsigned*)((LAS unsigned char*)lds + MISC_OFF) + 8);
    const int lo = args.ph_lo, hi = args.ph_hi; int ph = 0;
#ifndef PHSEL
#define PHSEL -1
#endif
#ifndef EBVAR
#define EBVAR 0
#endif
#ifndef REPMASK
#define REPMASK 0
#endif
#ifndef NULLEPI
#define NULLEPI 0
#endif
#define PH_BEGIN(k) if (lo <= ph && ph < hi) { for (int rep_ = 0; rep_ <= ((REPMASK >> (k)) & 1); ++rep_) { const bool dry_ = rep_ < ((REPMASK >> (k)) & 1); (void)dry_; Ctx C; { int t_ = threadIdx.x, b_ = blockIdx.x, g_ = gridDim.x; asm volatile("" : "+v"(t_), "+s"(b_), "+s"(g_)); C.lds = (LAS unsigned char*)lds; C.tid = t_; C.lane = t_ & 63; C.wave = __builtin_amdgcn_readfirstlane(t_ >> 6); \
        C.G = g_; C.vcu = (g_ % 8 == 0) ? (b_ % 8) * (g_ / 8) + b_ / 8 : b_; C.bx = b_; } \
    size_t z_ = 0; asm volatile("" : "+s"(z_)); unsigned char* ws = args.ws + z_; float* out = args.out + z_; const float* const* in = args.in;     \
    float* RS = (float*)(ws + WS_RSP); bf16* XB = (bf16*)(ws + WS_XB); bf16* OBF = (bf16*)(ws + WS_OB); bf16* PROJ = (bf16*)(ws + WS_PROJ); bf16* ACT = (bf16*)(ws + WS_ACT); \
    _Float16* LOGF = (_Float16*)(ws + WS_LOGF); bf16* KV = (bf16*)(ws + WS_KV); float* DEC = (float*)(ws + WS_DEC); bf16* ST = (bf16*)(ws + WS_ST); float* LF = (float*)(ws + WS_LF); \
    (void)RS; (void)XB; (void)OBF; (void)PROJ; (void)ACT; (void)LOGF; (void)KV; (void)DEC; (void)ST; (void)LF; (void)in; (void)out;
#define PH_END   if (dry_) { xcd_barrier(bar); } } if (ph + 1 < hi) { xcd_barrier(bar); } } ++ph;

    PH_BEGIN(0) if (PHSEL < 0 || PHSEL == 0) p0_prologue(C, in, ws, RS); PH_END

    for (int l = 0; l < DEPTH; ++l) {
        const int j = l >> 1;
        if ((l & 1) == 0) {
            PH_BEGIN(1) if (PHSEL < 0 || PHSEL == 1) {
                pg8::Gemm g{XB, (const bf16*)(ws + WS_WIE) + (size_t)j * EVEN_IN * DM, M, EVEN_IN, DM}; pg8::StaticOrder S; S.init(M, EVEN_IN, C.G, C.bx);
                pg8::Unit u0; S.next(0, u0); prep_rstd(C, RS, u0.pm, (LAS float*)(C.lds + CS_OFF + 8192));
                pg8::EpiEven E{PROJ, LOGF, pg8::RstdLds{(PG8_LAS float*)(C.lds + CS_OFF + 8192)}, in[5], j};
                if (NULLEPI == 1 && dry_) { pg8::EpiNull EN{(float*)(ws + WS_ST)}; pg8::gemm_phase<pg8::EpiNull, pg8::StaticOrder, true, true>(C.lds, g, S, EN); }
                else pg8::gemm_phase<pg8::EpiEven, pg8::StaticOrder, true, true>(C.lds, g, S, E); } PH_END
            PH_BEGIN(2) if (PHSEL < 0 || PHSEL == 2) even_ea(C, PROJ, LOGF, (float*)(ws + WS_KV), DEC); PH_END
            PH_BEGIN(4) if (PHSEL < 0 || PHSEL == 4) { if (dry_) even_eb<EBVAR>(C, PROJ, LOGF, (const float*)(ws + WS_KV), DEC, in[6] + j * DH, in[7] + j * DH, OBF); else even_eb<0>(C, PROJ, LOGF, (const float*)(ws + WS_KV), DEC, in[6] + j * DH, in[7] + j * DH, OBF); } PH_END
        } else {
            PH_BEGIN(5) if (PHSEL < 0 || PHSEL == 5) {
                pg8::Gemm g{XB, (const bf16*)(ws + WS_WIO) + (size_t)j * 8192 * DM, M, 8192, DM}; pg8::StaticOrder S; S.init(M, 8192, C.G, C.bx);
                pg8::Unit u0; S.next(0, u0); prep_rstd(C, RS, u0.pm, (LAS float*)(C.lds + CS_OFF + 8192));
                pg8::EpiOdd E{PROJ, PROJ + (size_t)3 * M * DM, pg8::RstdLds{(PG8_LAS float*)(C.lds + CS_OFF + 8192)}, (unsigned*)(ws + WS_CTL) + CW_NRM + (l >> 1) * 512, (PG8_LAS float*)(C.lds + CS_OFF)};
                if (NULLEPI == 1 && dry_) { pg8::EpiNull EN{(float*)(ws + WS_ST)}; pg8::gemm_phase<pg8::EpiNull, pg8::StaticOrder, true, true>(C.lds, g, S, EN); }
                else if (NULLEPI == 2 && dry_) { pg8::EpiProbe<1> EP{(bf16*)(ws + 940 * MiB), (bf16*)(ws + 940 * MiB) + (size_t)3 * M * DM, RS}; pg8::gemm_phase<pg8::EpiProbe<1>, pg8::StaticOrder, true, true>(C.lds, g, S, EP); }
                else if (NULLEPI == 3 && dry_) { pg8::EpiProbe<2> EP{(bf16*)(ws + 940 * MiB), (bf16*)(ws + 940 * MiB) + (size_t)3 * M * DM, RS}; pg8::gemm_phase<pg8::EpiProbe<2>, pg8::StaticOrder, true, true>(C.lds, g, S, EP); }
                else if (NULLEPI == 4 && dry_) { pg8::EpiProbe<3> EP{(bf16*)(ws + 940 * MiB), (bf16*)(ws + 940 * MiB) + (size_t)3 * M * DM, RS}; pg8::gemm_phase<pg8::EpiProbe<3>, pg8::StaticOrder, true, true>(C.lds, g, S, EP); }
                else pg8::gemm_phase<pg8::EpiOdd, pg8::StaticOrder, true, true>(C.lds, g, S, E);
                flogit_phase(C, XB, (const bf16*)(ws + WS_WF) + (size_t)j * 16 * DM, RS, in[10] + j * NFOX, LF); } PH_END
            PH_BEGIN(6) if (PHSEL < 0 || PHSEL == 6) { fox_phase(C, (char*)lds, PROJ, PROJ + (size_t)M * DM, PROJ + (size_t)2 * M * DM, PROJ + (size_t)3 * M * DM, OBF, LF, (const unsigned*)(ws + WS_CTL) + CW_NRM + (l >> 1) * 512, in[10] + j * NFOX);
                if (!dry_) conv_filler(l >> 1, in, ws, (unsigned*)(ws + WS_CTL) + CW_CONVQ + (l >> 1) * 64, C.lds); } PH_END
        }
        PH_BEGIN(7) if (PHSEL < 0 || PHSEL == 7) {
            const bf16* wo = (l & 1) ? (const bf16*)(ws + WS_WOO) + (size_t)j * DM * DM : (const bf16*)(ws + WS_WOE) + (size_t)j * DM * DM;
            pg8::Gemm g{OBF, wo, M, DM, DM}; pg8::StaticOrder S; S.init(M, DM, C.G, C.bx);
            pg8::EpiResid E{dry_ ? (bf16*)(ws + WS_ST) : XB, RS};
            if (NULLEPI == 1 && dry_) { pg8::EpiNull EN{(float*)(ws + WS_ST)}; pg8::gemm_phase<pg8::EpiNull, pg8::StaticOrder, true, true>(C.lds, g, S, EN); }
            else pg8::gemm_phase<pg8::EpiResid, pg8::StaticOrder, true, true>(C.lds, g, S, E); } PH_END
        PH_BEGIN(8) if (PHSEL < 0 || PHSEL == 8) {
            pg8::Gemm g{XB, (const bf16*)(ws + WS_WU) + (size_t)l * DFF2 * DM, M, DFF2, DM}; pg8::StaticOrder S; S.init(M, DFF2, C.G, C.bx);
            pg8::Unit u0; S.next(0, u0); prep_rstd(C, RS, u0.pm, (LAS float*)(C.lds + CS_OFF + 8192));
            pg8::EpiUpConv E{ACT, (float*)(ws + WS_SB), pg8::RstdLds{(PG8_LAS float*)(C.lds + CS_OFF + 8192)}, in[13] + (size_t)l * 3 * DFF2, (PG8_LAS float*)(C.lds + CS_OFF)};
            if (NULLEPI == 1 && dry_) { pg8::EpiNull EN{(float*)(ws + WS_ST)}; pg8::gemm_phase<pg8::EpiNull, pg8::StaticOrder, true, true>(C.lds, g, S, EN); }
            else pg8::gemm_phase<pg8::EpiUpConv, pg8::StaticOrder, true, true>(C.lds, g, S, E);
            if (!dry_ && l < 3) conv_filler(2 + l, in, ws, (unsigned*)(ws + WS_CTL) + CW_CONVQ + (2 + l) * 64, C.lds); } PH_END
        PH_BEGIN(9) if (PHSEL < 0 || PHSEL == 9) conv_fix(C, (const float*)(ws + WS_SB), in[13] + (size_t)l * 3 * DFF2, ACT); PH_END
        PH_BEGIN(10) if (PHSEL < 0 || PHSEL == 10) {
            pg8::Gemm g{ACT, (const bf16*)(ws + WS_WD) + (size_t)l * DM * DFF, M, DM, DFF}; pg8::StaticOrder S; S.init(M, DM, C.G, C.bx);
            pg8::EpiResid E{dry_ ? (bf16*)(ws + WS_ST) : XB, RS};
            if (NULLEPI == 1 && dry_) { pg8::EpiNull EN{(float*)(ws + WS_ST)}; pg8::gemm_phase<pg8::EpiNull, pg8::StaticOrder, true, true>(C.lds, g, S, EN); }
            else pg8::gemm_phase<pg8::EpiResid, pg8::StaticOrder, true, true>(C.lds, g, S, E); } PH_END
    }
    PH_BEGIN(11) if (PHSEL < 0 || PHSEL == 11) final_norm(C, XB, out, RS, in[3]); PH_END
#undef PH_BEGIN
#undef PH_END
}

extern "C" void kernel_launch(void* const* d_in, const int* in_sizes, int n_in, void* d_out, int out_size, void* d_ws, size_t ws_size, hipStream_t stream) {
    static int grid = 0;
    if (grid == 0) {
        if (n_in != 15 || in_sizes[0] != M * DM || out_size != M * DM || ws_size < WS_END) { fprintf(stderr, "kernel_launch: shape/workspace mismatch (n_in %d, in0 %d, out %d, ws %zu < %zu); nothing launched\n", n_in, n_in > 0 ? in_sizes[0] : -1, out_size, ws_size, (size_t)WS_END); grid = -1; return; }
        int dev = 0, cus = 0, per_cu = 0;
        if (hipGetDevice(&dev) != hipSuccess || hipDeviceGetAttribute(&cus, hipDeviceAttributeMultiprocessorCount, dev) != hipSuccess) { fprintf(stderr, "kernel_launch: device query failed\n"); grid = -1; return; }
        if (hipFuncSetAttribute((const void*)mk_fwd, hipFuncAttributeMaxDynamicSharedMemorySize, LDS_BYTES) != hipSuccess) { fprintf(stderr, "kernel_launch: hipFuncSetAttribute(%d B LDS) failed\n", LDS_BYTES); grid = -1; return; }
        if (hipOccupancyMaxActiveBlocksPerMultiprocessor(&per_cu, (const void*)mk_fwd, NWAVES * 64, LDS_BYTES) != hipSuccess || per_cu < 1) { fprintf(stderr, "kernel_launch: occupancy query reports %d workgroups per CU\n", per_cu); }
        (void)hipGetLastError();
        if (cus != 256) { fprintf(stderr, "kernel_launch: built for a 256-CU device (MI355X): the per-phase row-panel ownership of the GEMM phases assumes a 256-workgroup grid; this device has %d CUs; nothing launched\n", cus); grid = -1; return; }
        grid = cus;
    }
    if (grid < 0) return;
    if (hipMemsetAsync((char*)d_ws + WS_CTL, 0, CTL_ZERO_BYTES, stream) != hipSuccess) { fprintf(stderr, "kernel_launch: memset failed\n"); return; }
    Args a{};
    for (int i = 0; i < 15; ++i) a.in[i] = (const float*)d_in[i];
    a.out = (float*)d_out; a.ws = (unsigned char*)d_ws;
    if (MK_N_LAUNCHES == 1) { a.ph_lo = 0; a.ph_hi = N_PHASES; hipLaunchKernelGGL(mk_fwd, dim3(grid), dim3(NWAVES * 64), LDS_BYTES, stream, a); }
    else for (int p = 0; p < N_PHASES; ++p) { a.ph_lo = p; a.ph_hi = p + 1; hipLaunchKernelGGL(mk_fwd, dim3(grid), dim3(NWAVES * 64), LDS_BYTES, stream, a); }
    const hipError_t le = hipPeekAtLastError();
    if (le != hipSuccess) fprintf(stderr, "kernel_launch: launch failed: %s\n", hipGetErrorName(le));
}
```

```cpp
#include <hip/hip_runtime.h>
#include <cstdio>
#include <cstdint>
#define MK_N_LAUNCHES 1
namespace pg8 {
#define PG8_LAS __attribute__((address_space(3)))
typedef unsigned short bf16_t;
typedef short bf16x8 __attribute__((ext_vector_type(8)));
typedef float f32x4 __attribute__((ext_vector_type(4)));
typedef unsigned u32x4 __attribute__((ext_vector_type(4)));
constexpr int BM = 256, BK = 64, HALF = 128, HTB = HALF * BK * 2  , STAGE_BYTES = 8 * HTB, NXCD = 8, WGM = 8;

__host__ __device__ __forceinline__ int lds_byte(int r, int c) { const int st = (r >> 4) * 2 + (c >> 5), rr = r & 15, cc = c & 31, ob = rr * 64 + cc * 2; return st * 1024 + (ob ^ (((ob >> 9) & 1) << 5)); }
__host__ __device__ __forceinline__ void stage_rc(int b, int& R, int& C) { const int st = b / 1024, sb = b % 1024, swz = sb ^ (((sb >> 9) & 1) << 5); R = (st >> 1) * 16 + swz / 64; C = (st & 1) * 32 + (swz % 64) / 2; }
__host__ __device__ __forceinline__ int perm32(int rho) { const int n = rho >> 4, i = rho & 15; return 8 * (i >> 2) + 4 * n + (i & 3); }

struct Unit { int pm, pn; };
struct Gemm { const bf16_t* A; const bf16_t* Bt; int M, N, K; };

struct StaticOrder {
    int nM, nN, nwg, G, c;
    __host__ __device__ void init(int M, int N, int G_, int c_) { nM = M / BM; nN = N / BM; nwg = nM * nN; G = G_; c = c_; }
    __host__ __device__ __forceinline__ bool next(int i, Unit& u) const {
        const long L = (long)i * G + c; if (L >= nwg) return false;
        int wgid = (int)L; { const int q = nwg / NXCD, r = nwg % NXCD, xcd = wgid % NXCD, off = wgid / NXCD; wgid = (xcd < r ? xcd * (q + 1) : r * (q + 1) + (xcd - r) * q) + off; }
        const int nig = WGM * nN, gid = wgid / nig, fm = gid * WGM, gsz = (nM - fm) < WGM ? (nM - fm) : WGM;
        u.pm = fm + ((wgid % nig) % gsz); u.pn = (wgid % nig) / gsz; return true;
    }
    __device__ __forceinline__ void a_ready(const Unit&) const {}
    __device__ __forceinline__ void done(const Unit&) const {}
};
__device__ __forceinline__ int lane_now() { int l; asm volatile("v_mbcnt_lo_u32_b32 %0, -1, 0\n\tv_mbcnt_hi_u32_b32 %0, -1, %0" : "=v"(l)); return l; }
__device__ __forceinline__ float shfl_xor_l(float v, int m, int lane) { return __builtin_bit_cast(float, __builtin_amdgcn_ds_bpermute((lane ^ m) << 2, __builtin_bit_cast(int, v))); }
__device__ __forceinline__ float shfl_up_l(float v, int d, int lane) { return __builtin_bit_cast(float, __builtin_amdgcn_ds_bpermute((lane - d) << 2, __builtin_bit_cast(int, v))); }
__device__ __forceinline__ unsigned cvt_pk_bf16(float lo, float hi) { unsigned r; asm volatile("s_nop 0\n\tv_cvt_pk_bf16_f32 %0, %1, %2" : "=v"(r) : "v"(lo), "v"(hi)); return r; }
typedef float cvt_f32x2 __attribute__((ext_vector_type(2)));
typedef __bf16 cvt_bf16x2 __attribute__((ext_vector_type(2)));
__device__ __forceinline__ unsigned cvt_pk_bf16_c(float lo, float hi) { const cvt_bf16x2 v = __builtin_convertvector((cvt_f32x2){lo, hi}, cvt_bf16x2); return __builtin_bit_cast(unsigned, v); }
typedef unsigned u32x2 __attribute__((ext_vector_type(2)));
typedef float f32x2 __attribute__((ext_vector_type(2)));
typedef _Float16 h16x8 __attribute__((ext_vector_type(8)));
constexpr int EM = 16384, ED = 2048;
constexpr float RMS_EPS = 1e-6f;
__device__ __forceinline__ float fsigmoid(float x) { return __builtin_amdgcn_rcpf(1.f + __expf(-x)); }
__device__ __forceinline__ float row_rstd(const float* rsp, int row, int fq) { const f32x4 a = *(const f32x4*)(rsp + (size_t)row * 32 + fq * 8), b = *(const f32x4*)(rsp + (size_t)row * 32 + fq * 8 + 4);
    float s = ((a[0] + a[1]) + (a[2] + a[3])) + ((b[0] + b[1]) + (b[2] + b[3])); { const int l_ = lane_now(); s += shfl_xor_l(s, 16, l_); s += shfl_xor_l(s, 32, l_); } return __builtin_amdgcn_rsqf(s * (1.0f / (float)ED) + RMS_EPS); }
struct RstdLds { const PG8_LAS float* tab; };
__device__ __forceinline__ void rstd_get8(const RstdLds& R, int rloc0, float (&r)[2][4]) {
#pragma unroll
    for (int ai = 0; ai < 2; ++ai)
#pragma unroll
        for (int m = 0; m < 4; ++m) r[ai][m] = R.tab[rloc0 + ai * HALF + m * 16];
}
__device__ __forceinline__ u32x4 pack8f(const float (&v)[8]) { u32x4 w; w.x = cvt_pk_bf16(v[0], v[1]); w.y = cvt_pk_bf16(v[2], v[3]); w.z = cvt_pk_bf16(v[4], v[5]); w.w = cvt_pk_bf16(v[6], v[7]); return w; }

struct EpiResid {
    static constexpr bool PERM = true, AFTER_DRAIN = false;
    bf16_t* xb; float* rs;
    __device__ __forceinline__ void operator()(const f32x4 (&acc)[2][2][4][2], const Unit& u, int wr, int wc, int fr, int fq) const {
        const int row0 = u.pm * BM + wr * 64 + fr, col0 = u.pn * BM + wc * 32 + 8 * fq;
#pragma unroll
        for (int ai = 0; ai < 2; ++ai) {
            u32x4 xo[4][2];
#pragma unroll
            for (int m = 0; m < 4; ++m)
#pragma unroll
                for (int bj = 0; bj < 2; ++bj) xo[m][bj] = *(const u32x4*)(xb + (size_t)(row0 + ai * HALF + m * 16) * ED + col0 + bj * HALF);
#pragma unroll
            for (int m = 0; m < 4; ++m) { const int row = row0 + ai * HALF + m * 16; bf16_t* rowp = xb + (size_t)row * ED + col0; float ss = 0.f;
#pragma unroll
                for (int bj = 0; bj < 2; ++bj) { float v[8];
#pragma unroll
                    for (int e = 0; e < 4; ++e) { v[2 * e] = __uint_as_float(xo[m][bj][e] << 16) + acc[ai][bj][m][e >> 1][(2 * e) & 3]; v[2 * e + 1] = __uint_as_float(xo[m][bj][e] & 0xffff0000u) + acc[ai][bj][m][e >> 1][(2 * e + 1) & 3]; }
#pragma unroll
                    for (int e = 0; e < 8; ++e) ss += v[e] * v[e];
                    *(u32x4*)(rowp + bj * HALF) = pack8f(v); }
                { const int l_ = lane_now(); ss += shfl_xor_l(ss, 16, l_); ss += shfl_xor_l(ss, 32, l_); }
                if (fq == 0) rs[(size_t)row * 32 + u.pn * 4 + wc] = ss; }
            asm volatile("" ::: "memory"); }
    }
};
struct EpiUp {
    static constexpr bool PERM = true, AFTER_DRAIN = false;
    bf16_t* O; int ldc; const float* rs;
    __device__ __forceinline__ void operator()(const f32x4 (&acc)[2][2][4][2], const Unit& u, int wr, int wc, int fr, int fq) const {
        const int row0 = u.pm * BM + wr * 64 + fr, col0 = u.pn * BM + wc * 32 + 8 * fq;
#pragma unroll
        for (int ai = 0; ai < 2; ++ai)
#pragma unroll
            for (int m = 0; m < 4; ++m) { const int row = row0 + ai * HALF + m * 16; const float rstd = row_rstd(rs, row, fq); bf16_t* rowp = O + (size_t)row * ldc + col0;
#pragma unroll
                for (int bj = 0; bj < 2; ++bj) { const f32x4 v0 = acc[ai][bj][m][0] * rstd, v1 = acc[ai][bj][m][1] * rstd;
                    u32x4 w; w.x = cvt_pk_bf16(v0[0], v0[1]); w.y = cvt_pk_bf16(v0[2], v0[3]); w.z = cvt_pk_bf16(v1[0], v1[1]); w.w = cvt_pk_bf16(v1[2], v1[3]);
                    *(u32x4*)(rowp + bj * HALF) = w; } }
    }
};
__device__ __forceinline__ float dpp_prev1(float x, float p) { const int r = __builtin_amdgcn_update_dpp(0, __builtin_bit_cast(int, p), 0x121, 0xf, 0xf, false); return __builtin_bit_cast(float, __builtin_amdgcn_update_dpp(r, __builtin_bit_cast(int, x), 0x111, 0xf, 0xf, false)); }
__device__ __forceinline__ float dpp_prev2(float x, float p) { const int r = __builtin_amdgcn_update_dpp(0, __builtin_bit_cast(int, p), 0x122, 0xf, 0xf, false); return __builtin_bit_cast(float, __builtin_amdgcn_update_dpp(r, __builtin_bit_cast(int, x), 0x112, 0xf, 0xf, false)); }
struct EpiUpConv {
    static constexpr bool PERM = true, AFTER_DRAIN = false;
    bf16_t* act; float* sb; RstdLds rl; const float* cw; PG8_LAS float* halo;
    __device__ __forceinline__ void operator()(const f32x4 (&acc)[2][2][4][2], const Unit& u, int wr, int wc, int fr, int fq) const {
        const int row0 = u.pm * BM + wr * 64 + fr, cl = wc * 32 + 8 * fq, ccol = u.pn * 128 + cl;
        float rstd[2][4];
        rstd_get8(rl, wr * 64 + fr, rstd);
#pragma unroll
        for (int ai = 0; ai < 2; ++ai) { if (fr >= 14) { PG8_LAS float* hp = halo + ((2 * ai + wr) * 2 + (fr - 14)) * 256 + cl;
#pragma unroll
                for (int bj = 0; bj < 2; ++bj) { *(PG8_LAS f32x4*)(hp + bj * 128) = acc[ai][bj][3][0] * rstd[ai][3]; *(PG8_LAS f32x4*)(hp + bj * 128 + 4) = acc[ai][bj][3][1] * rstd[ai][3]; } } }
        if (wr == 0 && fr < 2) { float* sp = sb + ((size_t)(u.pm * 4 + fr)) * 11008 + u.pn * 256 + cl;
#pragma unroll
            for (int bj = 0; bj < 2; ++bj) { *(f32x4*)(sp + bj * 128) = acc[0][bj][0][0] * rstd[0][0]; *(f32x4*)(sp + bj * 128 + 4) = acc[0][bj][0][1] * rstd[0][0]; } }
        if (wr == 1 && fr >= 14) { float* sp = sb + ((size_t)(u.pm * 4 + 2 + (fr - 14))) * 11008 + u.pn * 256 + cl;
#pragma unroll
            for (int bj = 0; bj < 2; ++bj) { *(f32x4*)(sp + bj * 128) = acc[1][bj][3][0] * rstd[1][3]; *(f32x4*)(sp + bj * 128 + 4) = acc[1][bj][3][1] * rstd[1][3]; } }
        asm volatile("s_waitcnt lgkmcnt(0)" ::: "memory"); __builtin_amdgcn_s_barrier(); asm volatile("" ::: "memory");
        u32x2 pk0[2][4];
#pragma unroll
        for (int hf = 0; hf < 2; ++hf) {
            f32x2 w[3][4];
#pragma unroll
            for (int j = 0; j < 3; ++j) { const f32x4 a = *(const f32x4*)(cw + j * 11008 + ccol + 4 * hf), c = *(const f32x4*)(cw + j * 11008 + 5504 + ccol + 4 * hf);
#pragma unroll
                for (int e = 0; e < 4; ++e) w[j][e] = (f32x2){a[e], c[e]}; }
#pragma unroll
            for (int ai = 0; ai < 2; ++ai) {
                f32x2 p[4];
                const int sprev = 2 * ai + wr - 1;
                if (sprev >= 0 && fr >= 14) { const PG8_LAS float* hp = halo + (sprev * 2 + (fr - 14)) * 256 + cl + 4 * hf;
                    const f32x4 a = *(const PG8_LAS f32x4*)hp, c = *(const PG8_LAS f32x4*)(hp + 128);
#pragma unroll
                    for (int e = 0; e < 4; ++e) p[e] = (f32x2){a[e], c[e]}; }
                else {
#pragma unroll
                    for (int e = 0; e < 4; ++e) p[e] = (f32x2){0.f, 0.f}; }
#pragma unroll
                for (int m = 0; m < 4; ++m) { float o[4];
#pragma unroll
                    for (int e = 0; e < 4; ++e) { const f32x2 x0 = (f32x2){acc[ai][0][m][hf][e], acc[ai][1][m][hf][e]} * rstd[ai][m];
                        const f32x2 x1 = (f32x2){dpp_prev1(x0.x, p[e].x), dpp_prev1(x0.y, p[e].y)}, x2 = (f32x2){dpp_prev2(x0.x, p[e].x), dpp_prev2(x0.y, p[e].y)};
                        const f32x2 c = w[0][e] * x2 + w[1][e] * x1 + w[2][e] * x0;
                        o[e] = c.x * fsigmoid(c.x) * c.y; p[e] = x0; }
                    u32x2 w2; w2.x = cvt_pk_bf16(o[0], o[1]); w2.y = cvt_pk_bf16(o[2], o[3]);
                    if (hf == 0) pk0[ai][m] = w2;
                    else { u32x4 w4; w4.x = pk0[ai][m].x; w4.y = pk0[ai][m].y; w4.z = w2.x; w4.w = w2.y; *(u32x4*)(act + (size_t)(row0 + ai * HALF + m * 16) * 5504 + ccol) = w4; } }
            }
        }
    }
};
struct EpiEven {
    static constexpr bool PERM = true, AFTER_DRAIN = false;
    bf16_t* proj; _Float16* logf; RstdLds rl; const float* lbl;
    int jl;
    __device__ __forceinline__ void operator()(const f32x4 (&acc)[2][2][4][2], const Unit& u, int wr, int wc, int fr, int fq) const {
        const int seg = u.pn >> 2, cs0 = (u.pn & 3) * 256 + wc * 32 + 8 * fq, row0 = u.pm * BM + wr * 64 + fr;
        const size_t ho0 = (size_t)((u.pn & 3) * 2) * EM * 128 + wc * 32 + 8 * fq;
        bf16_t* segp = proj + (size_t)seg * EM * 1024;
        float rstd8[2][4];
        rstd_get8(rl, wr * 64 + fr, rstd8);
        if (seg == 1) {
            float lb[2][8];
#pragma unroll
            for (int bj = 0; bj < 2; ++bj)
#pragma unroll
                for (int e = 0; e < 8; ++e) { const int c = cs0 + bj * HALF + e; lb[bj][e] = jl ? fsigmoid(lbl[1024 + c] - lbl[c]) : 0.f; }
#pragma unroll
            for (int ai = 0; ai < 2; ++ai)
#pragma unroll
                for (int m = 0; m < 4; ++m) { const int row = row0 + ai * HALF + m * 16; const float rstd = rstd8[ai][m];
#pragma unroll
                    for (int bj = 0; bj < 2; ++bj) { h16x8 lh;
#pragma unroll
                        for (int e = 0; e < 8; ++e) { const float z = fminf(fmaxf(acc[ai][bj][m][e >> 2][e & 3] * rstd, -80.f), 80.f), ez = __expf(-z), sg = __builtin_amdgcn_rcpf(1.f + ez);
                            const float one_m = 1.f - lb[bj][e], f = fmaxf(lb[bj][e], 1e-30f) + one_m * sg, lf = __logf(f);
                            lh[e] = (_Float16)lf; }
                        const size_t o = ho0 + ((size_t)bj * EM + row) * 128;
                        *(h16x8*)(logf + o) = lh; } }
        } else if (seg == 4 || seg == 5) {
            const float sc = seg == 5 ? 0.08838834764831845f : 1.f;
            float invf[4];
#pragma unroll
            for (int i = 0; i < 4; ++i) invf[i] = exp2f(-(float)(wc * 16 + 4 * fq + i) * (13.287712379549449f / 64.f));
#pragma unroll
            for (int ai = 0; ai < 2; ++ai)
#pragma unroll
                for (int m = 0; m < 4; ++m) { const int row = row0 + ai * HALF + m * 16; const float rstd = rstd8[ai][m] * sc, tpos = (float)(row & 4095);
                    float cs[4], sn[4];
#pragma unroll
                    for (int i = 0; i < 4; ++i) { float rev = (tpos * invf[i]) * 0.15915494309189535f; rev = rev - floorf(rev); cs[i] = __builtin_amdgcn_cosf(rev); sn[i] = __builtin_amdgcn_sinf(rev); }
#pragma unroll
                    for (int bj = 0; bj < 2; ++bj) { float v[8];
#pragma unroll
                        for (int i = 0; i < 4; ++i) { const float x1 = acc[ai][bj][m][i >> 1][(2 * i) & 3] * rstd, x2 = acc[ai][bj][m][i >> 1][(2 * i + 1) & 3] * rstd;
                            v[2 * i] = x1 * cs[i] - x2 * sn[i]; v[2 * i + 1] = x2 * cs[i] + x1 * sn[i]; }
                        *(u32x4*)(segp + ho0 + ((size_t)bj * EM + row) * 128) = pack8f(v); } }
        } else {
            const bool act = (seg == 0 || seg == 3 || seg == 7);
#pragma unroll
            for (int ai = 0; ai < 2; ++ai)
#pragma unroll
                for (int m = 0; m < 4; ++m) { const int row = row0 + ai * HALF + m * 16; const float rstd = rstd8[ai][m];
#pragma unroll
                    for (int bj = 0; bj < 2; ++bj) { float v[8];
#pragma unroll
                        for (int e = 0; e < 8; ++e) { const float x = acc[ai][bj][m][e >> 2][e & 3] * rstd; v[e] = act ? x * fsigmoid(x) : x; }
                        *(u32x4*)(segp + ho0 + ((size_t)bj * EM + row) * 128) = pack8f(v); } }
        }
    }
};
struct EpiOdd {
    static constexpr bool PERM = true, AFTER_DRAIN = false;
    bf16_t* qkv; bf16_t* g; RstdLds rl;
    unsigned* nrm;
    PG8_LAS float* ex;
    __device__ __forceinline__ void operator()(const f32x4 (&acc)[2][2][4][2], const Unit& u, int wr, int wc, int fr, int fq) const {
        const int seg = u.pn >> 3, hh0 = (u.pn & 7) * 2, p0 = wc * 32 + 8 * fq, row0 = u.pm * BM + wr * 64 + fr;
        float rstd8[2][4];
        rstd_get8(rl, wr * 64 + fr, rstd8);
#pragma unroll
        for (int ai = 0; ai < 2; ++ai)
#pragma unroll
            for (int m = 0; m < 4; ++m) { const int row = row0 + ai * HALF + m * 16; const float rstd = rstd8[ai][m]; const int b = row >> 12, t = row & 4095;
#pragma unroll
                for (int bj = 0; bj < 2; ++bj) { float v[8]; const int hh = hh0 + bj;
#pragma unroll
                    for (int e = 0; e < 8; ++e) { const float x = acc[ai][bj][m][e >> 2][e & 3] * rstd; v[e] = (seg == 3) ? fsigmoid(x) : x; }
                    bf16_t* dst = (seg == 3) ? g + (size_t)row * ED + hh * 128 + p0 : qkv + (size_t)seg * EM * ED + ((size_t)(b * 16 + hh) * 4096 + t) * 128 + p0;
                    *(u32x4*)dst = pack8f(v);
                    if (seg < 2) { float s = 0.f;
#pragma unroll
                        for (int e = 0; e < 8; ++e) s += v[e] * v[e];
                        { const int l_ = lane_now(); s += shfl_xor_l(s, 16, l_); s += shfl_xor_l(s, 32, l_); }
                        if (fq == 0) ex[(wc * 2 + bj) * 256 + ai * HALF + wr * 64 + m * 16 + fr] = s; } } }
        if (seg < 2) {
            asm volatile("s_waitcnt lgkmcnt(0)" ::: "memory"); __builtin_amdgcn_s_barrier(); asm volatile("" ::: "memory");
            const int bj = wr, rl_ = wc * 64 + fq * 16 + fr;
            float s = (ex[(0 * 2 + bj) * 256 + rl_] + ex[(1 * 2 + bj) * 256 + rl_]) + (ex[(2 * 2 + bj) * 256 + rl_] + ex[(3 * 2 + bj) * 256 + rl_]);
            { const int l_ = lane_now();
#pragma unroll
              for (int o = 1; o < 64; o <<= 1) s = fmaxf(s, shfl_xor_l(s, o, l_)); }
            if (fr == 0 && fq == 0) atomicMax(nrm + (seg * 64 + (u.pm >> 4) * 16 + hh0 + bj) * 4, __float_as_uint(s)); }
    }
};

struct EpiNull {
    static constexpr bool PERM = false, AFTER_DRAIN = false;
    float* sink;
    __device__ __forceinline__ void operator()(const f32x4 (&acc)[2][2][4][2], const Unit& u, int wr, int wc, int fr, int fq) const {
        float s = 0.f;
#pragma unroll
        for (int ai = 0; ai < 2; ++ai)
#pragma unroll
            for (int bj = 0; bj < 2; ++bj)
#pragma unroll
                for (int m = 0; m < 4; ++m)
#pragma unroll
                    for (int n = 0; n < 2; ++n) s += (acc[ai][bj][m][n][0] + acc[ai][bj][m][n][1]) + (acc[ai][bj][m][n][2] + acc[ai][bj][m][n][3]);
        if (s == 123456.789f) sink[0] = s;
    }
};

template <int MODE> struct EpiProbe {
    static constexpr bool PERM = true, AFTER_DRAIN = false;
    bf16_t* qkv; bf16_t* g; const float* rs;
    __device__ __forceinline__ void operator()(const f32x4 (&acc)[2][2][4][2], const Unit& u, int wr, int wc, int fr, int fq) const {
        const int seg = u.pn >> 3, hh0 = (u.pn & 7) * 2, p0 = wc * 32 + 8 * fq, row0 = u.pm * BM + wr * 64 + fr;
        float sink = 0.f;
#pragma unroll
        for (int ai = 0; ai < 2; ++ai)
#pragma unroll
            for (int m = 0; m < 4; ++m) { const int row = row0 + ai * HALF + m * 16; const float rstd = MODE == 2 ? row_rstd(rs, row, fq) : (MODE == 3 ? 1.0001f : 1.f); const int b = row >> 12, t = row & 4095;
#pragma unroll
                for (int bj = 0; bj < 2; ++bj) { float v[8]; const int hh = hh0 + bj;
#pragma unroll
                    for (int e = 0; e < 8; ++e) { const float x = acc[ai][bj][m][e >> 2][e & 3] * rstd; v[e] = (MODE >= 2 && seg == 3) ? fsigmoid(x) : x; }
                    bf16_t* dst = (seg == 3) ? g + (size_t)row * ED + hh * 128 + p0 : qkv + (size_t)seg * EM * ED + ((size_t)(b * 16 + hh) * 4096 + t) * 128 + p0;
                    const u32x4 w = pack8f(v);
                    if (MODE == 1) *(u32x4*)dst = w; else sink += __uint_as_float(w.x ^ w.y ^ w.z ^ w.w); } }
        if (MODE >= 2 && sink == 123456.789f) qkv[0] = 1;
    }
};
template <class Epi, class Sched, bool ALIGN_EPI = false, bool SP2 = false>
__device__ __forceinline__ void gemm_phase(PG8_LAS unsigned char* lds, const Gemm g, const Sched& S, const Epi& E) {
    int tid_ = threadIdx.x; asm volatile("" : "+v"(tid_));
    const int tid = tid_, wid = __builtin_amdgcn_readfirstlane(tid >> 6), lane = tid & 63, wr = wid >> 2, wc = wid & 3, fr = lane & 15, fq = lane >> 4;
    const int K = g.K, nt = K / BK;
    unsigned voffA[2], voffB[2];
#pragma unroll
    for (int i = 0; i < 2; ++i) { int R, C; stage_rc(tid * 16 + i * 8192, R, C); const int Rb = Epi::PERM ? ((R & ~31) + perm32(R & 31)) : R;
        voffA[i] = (unsigned)(R * K + C) * 2u; voffB[i] = (unsigned)(Rb * K + C) * 2u; }
    const size_t kstep = (size_t)(BK * 2);
    const size_t hstep = (size_t)HALF * K * 2;
    const size_t tstep = 2 * hstep;
    const unsigned ldsw = (unsigned)wid * 1024u;
    const int aoff = lds_byte(wr * 64 + fr, fq * 8), boff = lds_byte(wc * 32 + fr, fq * 8);
#define PG8_SA(b, h) (((b) * 2 + (h)) * HTB)
#define PG8_SB(b, h) ((4 + (b) * 2 + (h)) * HTB)
#define PG8_STAGE(bufoff, gbase, voff) do { _Pragma("unroll") for (int _i = 0; _i < 2; ++_i) \
        __builtin_amdgcn_global_load_lds((const unsigned*)((const char*)(gbase) + (voff)[_i]), (PG8_LAS unsigned*)(lds + (bufoff) + ldsw + _i * 8192), 16, 0, 0); } while (0)
#define PG8_LDA(dst, b, h) do { _Pragma("unroll") for (int m = 0; m < 4; ++m) _Pragma("unroll") for (int k = 0; k < 2; ++k) dst[m][k] = *(const PG8_LAS bf16x8*)(lds + PG8_SA(b, h) + aoff + m * 2048 + k * 1024); } while (0)
#define PG8_LDB(dst, b, h) do { _Pragma("unroll") for (int n = 0; n < 2; ++n) _Pragma("unroll") for (int k = 0; k < 2; ++k) dst[n][k] = *(const PG8_LAS bf16x8*)(lds + PG8_SB(b, h) + boff + n * 2048 + k * 1024); } while (0)
#define PG8_MMA(ai, bj, At, Bt) do { __builtin_amdgcn_s_setprio(1); _Pragma("unroll") for (int m = 0; m < 4; ++m) _Pragma("unroll") for (int n = 0; n < 2; ++n) _Pragma("unroll") for (int k = 0; k < 2; ++k) \
        acc[ai][bj][m][n] = __builtin_amdgcn_mfma_f32_16x16x32_bf16(Bt[n][k], At[m][k], acc[ai][bj][m][n], 0, 0, 0); __builtin_amdgcn_s_setprio(0); } while (0)
#define PG8_WAIT_V(n) asm volatile("s_waitcnt vmcnt(" #n ")" ::: "memory")
#define PG8_WAIT_L(n) asm volatile("s_waitcnt lgkmcnt(" #n ")" ::: "memory")
#define PG8_BAR __builtin_amdgcn_s_barrier()
#define PG8_SCHED __builtin_amdgcn_sched_barrier(0)
    Unit cur, nxt; int ui = 0;
    if (!S.next(0, cur)) return;
    f32x4 acc[2][2][4][2];
#pragma unroll
    for (int a = 0; a < 2; ++a)
#pragma unroll
        for (int b = 0; b < 2; ++b)
#pragma unroll
            for (int m = 0; m < 4; ++m)
#pragma unroll
                for (int n = 0; n < 2; ++n) acc[a][b][m][n] = (f32x4){0.f, 0.f, 0.f, 0.f};
    bf16x8 At[4][2], B0[2][2], B1[2][2];
    const char* cA = (const char*)g.A + (size_t)cur.pm * tstep; const char* cB = (const char*)g.Bt + (size_t)cur.pn * tstep;
    S.a_ready(cur);
    if constexpr (SP2) {
        PG8_STAGE(PG8_SB(0, 0), cB, voffB); PG8_STAGE(PG8_SB(0, 1), cB + hstep, voffB); PG8_STAGE(PG8_SA(0, 0), cA, voffA); PG8_STAGE(PG8_SA(0, 1), cA + hstep, voffA);
        if (wr == 1) PG8_BAR;
        PG8_WAIT_V(2); PG8_BAR;
        PG8_STAGE(PG8_SB(1, 0), cB + kstep, voffB); PG8_STAGE(PG8_SA(1, 0), cA + kstep, voffA); PG8_STAGE(PG8_SB(1, 1), cB + hstep + kstep, voffB);
        PG8_WAIT_V(6); PG8_BAR;
    } else {
        PG8_STAGE(PG8_SB(0, 0), cB, voffB); PG8_STAGE(PG8_SA(0, 0), cA, voffA); PG8_STAGE(PG8_SB(0, 1), cB + hstep, voffB); PG8_STAGE(PG8_SA(0, 1), cA + hstep, voffA);
        if (wr == 1) PG8_BAR;
        PG8_WAIT_V(4); PG8_BAR;
        PG8_STAGE(PG8_SB(1, 0), cB + kstep, voffB); PG8_STAGE(PG8_SA(1, 0), cA + kstep, voffA); PG8_STAGE(PG8_SB(1, 1), cB + hstep + kstep, voffB);
        PG8_WAIT_V(6); PG8_BAR;
    }
    for (;;) {
        const bool has_next = S.next(ui + 1, nxt);
        const char* nA = has_next ? (const char*)g.A + (size_t)nxt.pm * tstep : cA; const char* nB = has_next ? (const char*)g.Bt + (size_t)nxt.pn * tstep : cB;
        for (int t = 0; t < nt; t += 2) {
            const bool last = (t == nt - 2);
            const char* a1 = cA + (size_t)(t + 1) * kstep;
            const char* a2 = last ? nA : cA + (size_t)(t + 2) * kstep; const char* b2 = last ? nB : cB + (size_t)(t + 2) * kstep;
            const char* a3 = a2 + kstep; const char* b3 = b2 + kstep;
            if (last && has_next) S.a_ready(nxt);
            if constexpr (SP2) {
            PG8_LDB(B0, 0, 0); PG8_LDB(B1, 0, 1); PG8_SCHED; PG8_LDA(At, 0, 0); PG8_STAGE(PG8_SA(1, 1), a1 + hstep, voffA);
            PG8_WAIT_V(8); PG8_WAIT_L(0); PG8_BAR; PG8_MMA(0, 0, At, B0); PG8_MMA(0, 1, At, B1); PG8_BAR; PG8_SCHED;
            PG8_LDA(At, 0, 1); PG8_STAGE(PG8_SB(0, 0), b2, voffB); PG8_STAGE(PG8_SB(0, 1), b2 + hstep, voffB); PG8_STAGE(PG8_SA(0, 0), a2, voffA);
            PG8_WAIT_V(8); PG8_WAIT_L(0); PG8_BAR; PG8_MMA(1, 0, At, B0); PG8_MMA(1, 1, At, B1); PG8_BAR; PG8_SCHED;
            PG8_LDB(B0, 1, 0); PG8_LDB(B1, 1, 1); PG8_SCHED; PG8_LDA(At, 1, 0); PG8_STAGE(PG8_SA(0, 1), a2 + hstep, voffA);
            PG8_WAIT_V(8); PG8_WAIT_L(0); PG8_BAR; PG8_MMA(0, 0, At, B0); PG8_MMA(0, 1, At, B1); PG8_BAR; PG8_SCHED;
            PG8_LDA(At, 1, 1); PG8_STAGE(PG8_SB(1, 0), b3, voffB); PG8_STAGE(PG8_SB(1, 1), b3 + hstep, voffB); PG8_STAGE(PG8_SA(1, 0), a3, voffA);
            PG8_WAIT_V(8); PG8_WAIT_L(0); PG8_BAR; PG8_MMA(1, 0, At, B0); PG8_MMA(1, 1, At, B1); PG8_BAR; PG8_SCHED;
            } else {
            PG8_LDB(B0, 0, 0); PG8_SCHED; PG8_LDA(At, 0, 0); PG8_STAGE(PG8_SA(1, 1), a1 + hstep, voffA);
            PG8_WAIT_L(8); PG8_BAR; PG8_WAIT_L(0); PG8_MMA(0, 0, At, B0); PG8_BAR; PG8_SCHED;
            PG8_LDB(B1, 0, 1); PG8_STAGE(PG8_SB(0, 0), b2, voffB);
            PG8_BAR; PG8_WAIT_L(0); PG8_MMA(0, 1, At, B1); PG8_BAR;
            PG8_LDA(At, 0, 1); PG8_STAGE(PG8_SA(0, 0), a2, voffA);
            PG8_BAR; PG8_WAIT_L(0); PG8_MMA(1, 0, At, B0); PG8_BAR; PG8_SCHED;
            PG8_STAGE(PG8_SB(0, 1), b2 + hstep, voffB);
            PG8_WAIT_V(6); PG8_BAR; PG8_MMA(1, 1, At, B1); PG8_BAR;
            PG8_LDB(B0, 1, 0); PG8_SCHED; PG8_LDA(At, 1, 0); PG8_STAGE(PG8_SA(0, 1), a2 + hstep, voffA);
            PG8_WAIT_L(8); PG8_BAR; PG8_WAIT_L(0); PG8_MMA(0, 0, At, B0); PG8_BAR; PG8_SCHED;
            PG8_LDB(B1, 1, 1); PG8_STAGE(PG8_SB(1, 0), b3, voffB);
            PG8_BAR; PG8_WAIT_L(0); PG8_MMA(0, 1, At, B1); PG8_BAR;
            PG8_LDA(At, 1, 1); PG8_STAGE(PG8_SA(1, 0), a3, voffA);
            PG8_BAR; PG8_WAIT_L(0); PG8_MMA(1, 0, At, B0); PG8_BAR; PG8_SCHED;
            PG8_STAGE(PG8_SB(1, 1), b3 + hstep, voffB);
            PG8_WAIT_V(6); PG8_BAR; PG8_MMA(1, 1, At, B1); PG8_BAR;
            }
        }
        if constexpr (ALIGN_EPI) { if (wr == 0) PG8_BAR; }
        if constexpr (!Epi::AFTER_DRAIN) { E(acc, cur, wr, wc, fr, fq); S.done(cur); }
        if (!has_next) break;
#pragma unroll
        for (int a = 0; a < 2; ++a)
#pragma unroll
            for (int b = 0; b < 2; ++b)
#pragma unroll
                for (int m = 0; m < 4; ++m)
#pragma unroll
                    for (int n = 0; n < 2; ++n) acc[a][b][m][n] = (f32x4){0.f, 0.f, 0.f, 0.f};
        cur = nxt; cA = nA; cB = nB; ++ui;
        if constexpr (ALIGN_EPI) { if (wr == 1) PG8_BAR; }
    }
    PG8_WAIT_V(0);
    if constexpr (!ALIGN_EPI) { if (wr == 0) PG8_BAR; }
    PG8_BAR;
    if constexpr (Epi::AFTER_DRAIN) { E.fused(acc, cur, wr, wc, fr, fq, lds, wid, lane); S.done(cur); }
#undef PG8_SA
#undef PG8_SB
#undef PG8_STAGE
#undef PG8_LDA
#undef PG8_LDB
#undef PG8_MMA
#undef PG8_WAIT_V
#undef PG8_WAIT_L
#undef PG8_BAR
#undef PG8_SCHED
}
}
#include <hip/hip_bf16.h>
namespace fox {
enum { ORDER_NATURAL = 0, ORDER_REVERSED = 1, ORDER_PAIRED = 2, ORDER_XCD = 4 };
constexpr int B = 4, H = 16, HKV = 16, SQ = 4096, SKV = 4096, D = 128, QOFF = 0, WINDOW = SKV, OP = 2048;
constexpr float THR = 8.f;
constexpr int ORDER = ORDER_PAIRED;
constexpr bool WSKIP = false;
constexpr float SCALE = 0.08838834764831845f;
constexpr int NW = 8, QBLK = 32, KVBLK = 64, QB = NW * QBLK;
constexpr int SHM_V = KVBLK * D * 2, SHM_K = KVBLK * D * 2;
constexpr int LDS_BYTES = 2 * SHM_V + 2 * SHM_K + NW * 64 * 4;
constexpr int OST_OFF = LDS_BYTES, OST_BYTES = NW * 8192;
static_assert(D == 128 && SQ % QB == 0 && SKV % KVBLK == 0 && H % HKV == 0 && QOFF >= 0 && QOFF + SQ <= SKV && WINDOW >= 1, "geometry");

using bf16 = __hip_bfloat16;
typedef short bf16x8 __attribute__((ext_vector_type(8)));
typedef short s16x4 __attribute__((ext_vector_type(4)));
typedef float f32x16 __attribute__((ext_vector_type(16)));
typedef float f32x4 __attribute__((ext_vector_type(4)));
typedef unsigned u32x4 __attribute__((ext_vector_type(4)));
template <class A, class Bt> struct same_t { static constexpr bool v = false; };
template <class A> struct same_t<A, A> { static constexpr bool v = true; };

#define KSWZ(row, colB) ((row) * 256 + ((colB) ^ (((row) & 7) << 4)))
#define SBAR() __builtin_amdgcn_sched_barrier(0)
__device__ __forceinline__ int v_st(int k, int c) { const int kk = (k & ~0xC) | ((k & 4) << 1) | ((k & 8) >> 1); return ((kk >> 3) * 4 + (c >> 5)) * 512 + ((kk & 7) * 32 + (c & 31)) * 2; }
__device__ __forceinline__ int v_rd_base(int lane) { return ((lane & 3) << 3) | (((lane >> 2) & 3) << 6) | (((lane >> 4) & 1) << 5) | (((lane >> 5) & 1) << 8); }
constexpr int v_rd_off(int d0, int ks, int half) { return d0 * 512 + ks * 4096 + half * 2048; }
__device__ __forceinline__ int crow(int r, int hi) { return (r & 3) + 8 * (r >> 2) + 4 * hi; }
__device__ __forceinline__ unsigned cvtpk(float lo, float hi) {
    unsigned r; asm volatile("s_nop 0\n\tv_cvt_pk_bf16_f32 %0, %1, %2" : "=v"(r) : "v"(lo), "v"(hi)); return r;
}
__device__ __forceinline__ bf16x8 pack8(f32x4 a, f32x4 b) {
    u32x4 w = {cvtpk(a[0], a[1]), cvtpk(a[2], a[3]), cvtpk(b[0], b[1]), cvtpk(b[2], b[3])};
    return *reinterpret_cast<bf16x8*>(&w);
}
template <class T> __device__ __forceinline__ bf16x8 load8(const T* p) {
    if constexpr (same_t<T, float>::v) { return pack8(*(const f32x4*)p, *(const f32x4*)(p + 4)); }
    else { return *reinterpret_cast<const bf16x8*>(p); }
}
__device__ __forceinline__ void mask_tile(f32x16& p0, f32x16& p1, int dq, unsigned W) {
    const float NEG = -__builtin_inff();
#pragma unroll
    for (int r = 0; r < 16; ++r) {
        const int c = (r & 3) + 8 * (r >> 2);
        if ((unsigned)(dq - c) >= W) p0[r] = NEG;
        if ((unsigned)(dq - c - 32) >= W) p1[r] = NEG;
    }
}
__device__ __forceinline__ void partialSM(f32x16& p0, f32x16& p1, float& m_reg, float& mn, float& alpha) {
    float pmax = p0[0]; for (int r = 1; r < 16; ++r) pmax = fmaxf(pmax, p0[r]); for (int r = 0; r < 16; ++r) pmax = fmaxf(pmax, p1[r]);
    { auto rr = __builtin_amdgcn_permlane32_swap(__float_as_uint(pmax), __float_as_uint(pmax), false, false);
      pmax = fmaxf(__uint_as_float(rr[0]), __uint_as_float(rr[1])); }
    constexpr float C2 = 1.4426950408889634f * SCALE;
    if (__builtin_expect(__all((pmax - m_reg) * SCALE <= THR), 1)) { mn = m_reg; alpha = 1.f; }
    else { mn = fmaxf(m_reg, pmax); alpha = __builtin_amdgcn_exp2f((m_reg - mn) * C2); m_reg = mn; }
    const float mnL = -mn * C2;
    for (int r = 0; r < 16; ++r) p0[r] = fmaf(p0[r], C2, mnL); for (int r = 0; r < 16; ++r) p1[r] = fmaf(p1[r], C2, mnL);
    for (int r = 0; r < 16; ++r) p0[r] = __builtin_amdgcn_exp2f(p0[r]);
}
__device__ __forceinline__ void finishSM(f32x16& p0, f32x16& p1, float alpha, float& l_reg, bf16x8& pa0, bf16x8& pa1, bf16x8& pa2, bf16x8& pa3) {
    for (int r = 0; r < 16; ++r) p1[r] = __builtin_amdgcn_exp2f(p1[r]);
    float ps = 0; for (int r = 0; r < 16; ++r) ps += p0[r]; for (int r = 0; r < 16; ++r) ps += p1[r];
    { auto rr = __builtin_amdgcn_permlane32_swap(__float_as_uint(ps), __float_as_uint(ps), false, false);
      ps = __uint_as_float(rr[0]) + __uint_as_float(rr[1]); }
    l_reg = l_reg * alpha + ps;
#define PK4(P, B_, OUT) do { unsigned a0 = cvtpk(P[B_+0], P[B_+1]), a1 = cvtpk(P[B_+2], P[B_+3]);                          \
        unsigned b0 = cvtpk(P[B_+4], P[B_+5]), b1 = cvtpk(P[B_+6], P[B_+7]);                                             \
        auto r0 = __builtin_amdgcn_permlane32_swap(a0, b0, false, false); auto r1 = __builtin_amdgcn_permlane32_swap(a1, b1, false, false); \
        u32x4 w = {r0[0], r1[0], r0[1], r1[1]}; OUT = *reinterpret_cast<bf16x8*>(&w); } while (0)
    PK4(p0, 0, pa0); PK4(p0, 8, pa1); PK4(p1, 0, pa2); PK4(p1, 8, pa3);
#undef PK4
}
template <int KB, bool SK>
__device__ __forceinline__ void qkt(f32x16& p0, f32x16& p1, const char* K_lds, int r32, int hi, const bf16x8* qr, bool act, const __attribute__((address_space(3))) float* csk) {
    if (SK && !act) { const float NEG = -__builtin_inff();
#pragma unroll
        for (int r = 0; r < 16; ++r) { p0[r] = NEG; p1[r] = NEG; } return; }
    {
        typedef __attribute__((address_space(3))) f32x4 lf4; const lf4* cb = (const lf4*)(csk + 4 * hi);
        const f32x4 a0 = cb[0], a1 = cb[2], a2 = cb[4], a3 = cb[6], b0 = cb[8], b1 = cb[10], b2 = cb[12], b3 = cb[14];
        p0 = __builtin_shufflevector(__builtin_shufflevector(a0, a1, 0, 1, 2, 3, 4, 5, 6, 7), __builtin_shufflevector(a2, a3, 0, 1, 2, 3, 4, 5, 6, 7), 0, 1, 2, 3, 4, 5, 6, 7, 8, 9, 10, 11, 12, 13, 14, 15);
        p1 = __builtin_shufflevector(__builtin_shufflevector(b0, b1, 0, 1, 2, 3, 4, 5, 6, 7), __builtin_shufflevector(b2, b3, 0, 1, 2, 3, 4, 5, 6, 7), 0, 1, 2, 3, 4, 5, 6, 7, 8, 9, 10, 11, 12, 13, 14, 15); }
    const char* kb[4];
#pragma unroll
    for (int dd = 0; dd < 4; ++dd) kb[dd] = K_lds + KB * SHM_K + KSWZ(r32, (dd * 16 + hi * 8) * 2);
#pragma unroll
    for (int d0 = 0; d0 < 8; ++d0) { const char* a = kb[d0 & 3] + (d0 >> 2) * 128;
        bf16x8 b0 = *reinterpret_cast<const bf16x8*>(a);
        bf16x8 b1 = *reinterpret_cast<const bf16x8*>(a + 32 * 256);
        p0 = __builtin_amdgcn_mfma_f32_32x32x16_bf16(b0, qr[d0], p0, 0, 0, 0);
        p1 = __builtin_amdgcn_mfma_f32_32x32x16_bf16(b1, qr[d0], p1, 0, 0, 0); }
}
template <int VB, bool SK>
__device__ __forceinline__ void pv_tile(f32x16* o, int vb0, bf16x8 pa0, bf16x8 pa1, bf16x8 pa2, bf16x8 pa3, bool act) {
    if (SK && !act) return;
#define TRRD(dst, off) asm volatile("ds_read_b64_tr_b16 %0, %1 offset:%2" : "=&v"(dst) : "v"(vb0), "i"(off) : "memory")
#define PV_D0(d0) do { s16x4 l0, l1, l2, l3, h0, h1, h2, h3; constexpr int b_ = VB * SHM_V + v_rd_off(d0, 0, 0);     \
        TRRD(l0, b_); TRRD(h0, b_ + 2048); TRRD(l1, b_ + 4096); TRRD(h1, b_ + 6144); TRRD(l2, b_ + 8192); TRRD(h2, b_ + 10240); TRRD(l3, b_ + 12288); TRRD(h3, b_ + 14336); \
        asm volatile("s_waitcnt lgkmcnt(0)" ::: "memory"); SBAR();                 \
        o[d0] = __builtin_amdgcn_mfma_f32_32x32x16_bf16(pa0, (bf16x8){l0[0], l0[1], l0[2], l0[3], h0[0], h0[1], h0[2], h0[3]}, o[d0], 0, 0, 0);   \
        o[d0] = __builtin_amdgcn_mfma_f32_32x32x16_bf16(pa1, (bf16x8){l1[0], l1[1], l1[2], l1[3], h1[0], h1[1], h1[2], h1[3]}, o[d0], 0, 0, 0);   \
        o[d0] = __builtin_amdgcn_mfma_f32_32x32x16_bf16(pa2, (bf16x8){l2[0], l2[1], l2[2], l2[3], h2[0], h2[1], h2[2], h2[3]}, o[d0], 0, 0, 0);   \
        o[d0] = __builtin_amdgcn_mfma_f32_32x32x16_bf16(pa3, (bf16x8){l3[0], l3[1], l3[2], l3[3], h3[0], h3[1], h3[2], h3[3]}, o[d0], 0, 0, 0); } while (0)
    PV_D0(0); PV_D0(1); PV_D0(2); PV_D0(3);
#undef PV_D0
#undef TRRD
}

template <class TIn, class TOut> struct BlockRef { const TIn* Q; const TIn* K; const TIn* V; TOut* O; int P0; float thr; };
template <class TIn> struct Seam {
    bf16x8 qr[8];
    bf16x8 st_v0, st_v1, st_k0, st_k1; f32x4 sf0, sf1, sf2, sf3;
    f32x4 tq[16];
};
__device__ __forceinline__ int swa_jlo(int P0, int W) { const int lowk = P0 - W + 1; return lowk > 0 ? lowk / KVBLK : 0; }
__device__ __forceinline__ int fox_jlo(const __attribute__((address_space(3))) float* ncs, int P0, float thr) {
    int l = threadIdx.x; asm volatile("" : "+v"(l)); l &= 63;
    float e = 3.2086e-10f * __expf(fminf((thr - (ncs[P0] - ncs[64 * l + 63])) * 0.08838834764831845f, 80.f));
#pragma unroll
    for (int o = 1; o < 64; o <<= 1) { const float u = pg8::shfl_up_l(e, o, l); e += (l >= o) ? u : 0.f; }
    return __builtin_amdgcn_readfirstlane(__builtin_ctzll(__ballot(e >= 3e-8f)));
}
#define ROW(p, k0, rr) ((p) + (size_t)((k0) + (rr)) * D + sc)
#define VMW() asm volatile("s_waitcnt vmcnt(0)" ::: "memory")
#define VMWN(n) asm volatile("s_waitcnt vmcnt(%0)" :: "i"(n) : "memory")
#define SLOAD_H(Kp, Vp, k0) do { S.st_v0 = load8<TIn>(ROW(Vp, k0, sr)); S.st_v1 = load8<TIn>(ROW(Vp, k0, 32 + sr));              \
                         S.st_k0 = load8<TIn>(ROW(Kp, k0, sr)); S.st_k1 = load8<TIn>(ROW(Kp, k0, 32 + sr)); } while (0)
#define SWRITE_HK(bf) do { *(bf16x8*)(K_lds + (bf) * SHM_K + kws) = S.st_k0; *(bf16x8*)(K_lds + (bf) * SHM_K + kws + 32 * 256) = S.st_k1; } while (0)
#define SWRITE_HV(bf) do { *(bf16x8*)(V_lds + (bf) * SHM_V + vst0) = S.st_v0; *(bf16x8*)(V_lds + (bf) * SHM_V + vst1) = S.st_v1; } while (0)
#define SWRITE_H(bf) do { SWRITE_HV(bf); SWRITE_HK(bf); } while (0)
#define SLOAD_F(p, k0) do { S.sf0 = *(const f32x4*)ROW(p, k0, sr); S.sf1 = *(const f32x4*)(ROW(p, k0, sr) + 4);                \
                            S.sf2 = *(const f32x4*)ROW(p, k0, 32 + sr); S.sf3 = *(const f32x4*)(ROW(p, k0, 32 + sr) + 4); } while (0)
#define SWRITE_KF(bf) do { *(bf16x8*)(K_lds + (bf) * SHM_K + kws) = pack8(S.sf0, S.sf1); *(bf16x8*)(K_lds + (bf) * SHM_K + kws + 32 * 256) = pack8(S.sf2, S.sf3); } while (0)
#define SWRITE_VF(bf) do { *(bf16x8*)(V_lds + (bf) * SHM_V + vst0) = pack8(S.sf0, S.sf1); *(bf16x8*)(V_lds + (bf) * SHM_V + vst1) = pack8(S.sf2, S.sf3); } while (0)
template <class TIn, class TOut>
__device__ __forceinline__ void causal_swa_prime(const BlockRef<TIn, TOut>& cur, int W, char* lds, Seam<TIn>& S, const __attribute__((address_space(3))) float* ncs) {
    constexpr bool F32 = same_t<TIn, float>::v;
    int tid_ = threadIdx.x; asm volatile("" : "+v"(tid_));
    const int tid = tid_, wid = __builtin_amdgcn_readfirstlane(tid >> 6), lane = tid & 63, r32 = lane & 31, hi = lane >> 5;
    const int sr = tid >> 4, sc = (tid & 15) * 8, kws = KSWZ(sr, sc * 2); char* K_lds = lds + 2 * SHM_V;
    const int kb0 = fox_jlo(ncs, cur.P0, cur.thr) * KVBLK;
    for (int d0 = 0; d0 < 8; ++d0) S.qr[d0] = load8<TIn>(cur.Q + (size_t)(wid * QBLK + r32) * D + d0 * 16 + hi * 8);
    if constexpr (F32) { SLOAD_F((const float*)cur.K, kb0); VMW(); SWRITE_KF(0); SBAR(); SLOAD_F((const float*)cur.V, kb0); }
    else { SLOAD_H(cur.K, cur.V, kb0); VMW(); SWRITE_HK(0); }
    __syncthreads();
}
template <class TIn, class TOut>
__device__ __forceinline__ void causal_swa_block(const BlockRef<TIn, TOut>& cur, const BlockRef<TIn, TOut>& nxt, int skv, int W, char* lds, Seam<TIn>& S, const __attribute__((address_space(3))) float* cs, long gdelta) {
    constexpr bool F32 = same_t<TIn, float>::v;
    int tid_ = threadIdx.x; asm volatile("" : "+v"(tid_));
    const int tid = tid_, wid = __builtin_amdgcn_readfirstlane(tid >> 6), lane = tid & 63, r32 = lane & 31, hi = lane >> 5;
    const int j_lo = fox_jlo(cs, cur.P0, cur.thr);
    int j_hi = (cur.P0 + QB - 1) / KVBLK + 1; if (j_hi > skv / KVBLK) j_hi = skv / KVBLK;
    const int NT = j_hi - j_lo;
    const int kbn = fox_jlo(cs, nxt.P0, nxt.thr) * KVBLK;
    const int qlo = cur.P0 + wid * QBLK, qm = qlo + r32 - 4 * hi;
    char* V_lds = lds; char* K_lds = lds + 2 * SHM_V;
    float* ws = (float*)(lds + 2 * SHM_V + 2 * SHM_K) + wid * 64; float* li_l = ws, * al_l = ws + 32;
    float m_reg = -1e30f, l_reg = 0; f32x16 o[4] = {};
    const int sr = tid >> 4, sc = (tid & 15) * 8, vst0 = v_st(sr, sc), vst1 = v_st(32 + sr, sc), kws = KSWZ(sr, sc * 2);
    const int vb0 = (int)(uintptr_t)V_lds + v_rd_base(lane);
    const TIn* Kh = cur.K; const TIn* Vh = cur.V;
#define RESC(a) do { if (__any((a) < 1.f)) { if (hi == 0) al_l[r32] = (a); asm volatile("s_waitcnt lgkmcnt(0)" ::: "memory");              \
                     for (int d_ = 0; d_ < 4; ++d_) for (int r = 0; r < 16; ++r) o[d_][r] *= al_l[crow(r, hi)]; } } while (0)
#define KBASE(t) ((j_lo + (t)) * KVBLK)
#define ACT(t) (KBASE(t) <= qlo + QBLK - 1 && KBASE(t) + KVBLK - 1 >= qlo - W + 1)
#define MASKT(P0_, P1_, t) do { const int kb_ = KBASE(t); if ((!SK || ACT(t)) && (kb_ + KVBLK - 1 > qlo || kb_ <= qlo + QBLK - 1 - W)) mask_tile(P0_, P1_, qm - kb_, (unsigned)W); } while (0)
    constexpr int NQL = F32 ? 16 : 8;
    constexpr bool SK = WSKIP && !F32;
#define SEAM_K0() do { VMWN(NQL); if constexpr (F32) { SWRITE_KF(0); SBAR(); SLOAD_F((const float*)nxt.V, kbn); } else { SWRITE_HK(0); } SBAR(); } while (0)
    f32x16 pA0, pA1, pB0, pB1; float mnA, mnB, alA, alB; bf16x8 pa0, pa1, pa2, pa3;
    if constexpr (F32) { VMW(); SWRITE_VF(0); SBAR(); } else { SWRITE_HV(0); SBAR(); }
    if (NT > 1) { if constexpr (F32) SLOAD_F((const float*)Kh, KBASE(1)); else SLOAD_H(Kh, Vh, KBASE(1)); }
    SBAR(); qkt<0, SK>(pA0, pA1, K_lds, r32, hi, S.qr, ACT(0), cs + KBASE(0));
    if constexpr (F32) { if (NT > 1) { VMW(); SWRITE_KF(1); SBAR(); SLOAD_F((const float*)Vh, KBASE(1)); } }
    MASKT(pA0, pA1, 0); partialSM(pA0, pA1, m_reg, mnA, alA);
    if (NT > 1) { VMW(); if constexpr (F32) { SWRITE_VF(1); SBAR(); if (NT > 2) SLOAD_F((const float*)Kh, KBASE(2)); } else SWRITE_H(1); }
    __syncthreads();
#define HALF_STEP(PX0, PX1, mnX, alX, PY0, PY1, alY, t, KB, VB, SB) do {                                                      \
        SBAR(); qkt<KB, SK>(PX0, PX1, K_lds, r32, hi, S.qr, ACT(t), cs + KBASE(t));                                             \
        finishSM(PY0, PY1, alY, l_reg, pa0, pa1, pa2, pa3); SBAR();                                                           \
        if ((t) + 1 < NT) { if constexpr (F32) { VMW(); SWRITE_KF(SB); SBAR(); SLOAD_F((const float*)Vh, KBASE((t) + 1)); }  \
                            else { SLOAD_H(Kh, Vh, KBASE((t) + 1)); } SBAR(); }                                               \
        pv_tile<VB, SK>(o, vb0, pa0, pa1, pa2, pa3, ACT((t) - 1)); MASKT(PX0, PX1, (t)); partialSM(PX0, PX1, m_reg, mnX, alX);                                        \
        __syncthreads();                                                                                                      \
        if ((t) + 1 < NT) { VMW(); if constexpr (F32) { SWRITE_VF(SB); SBAR(); if ((t) + 2 < NT) SLOAD_F((const float*)Kh, KBASE((t) + 2)); } \
                            else { SWRITE_H(SB); } }                                                                          \
        RESC(alX); __syncthreads(); } while (0)
    for (int t = 1; t + 1 < NT; t += 2) {
        HALF_STEP(pB0, pB1, mnB, alB, pA0, pA1, alA, t, 1, 0, 0);
        HALF_STEP(pA0, pA1, mnA, alA, pB0, pB1, alB, t + 1, 0, 1, 1);
    }
    int tt_ = threadIdx.x; asm volatile("" : "+v"(tt_));
    const int widb = __builtin_amdgcn_readfirstlane(tt_ >> 6), laneb = tt_ & 63, r32b = laneb & 31, hib = laneb >> 5;
    const bool even = (NT & 1) == 0;
    if (even) { SBAR(); qkt<1, SK>(pB0, pB1, K_lds, r32, hi, S.qr, ACT(NT - 1), cs + KBASE(NT - 1)); SBAR(); }
#define QROW(e) (nxt.Q + (size_t)(wid * QBLK + r32) * D + ((e) >> 1) * 16 + hi * 8 + ((e) & 1) * 4)
    if constexpr (F32) { SLOAD_F((const float*)nxt.K, kbn); SBAR();
#pragma unroll
        for (int e = 0; e < 8; ++e) S.tq[e] = *(const f32x4*)QROW(e); }
    else { SLOAD_H(nxt.K, nxt.V, kbn); SBAR();
#pragma unroll
        for (int d0 = 0; d0 < 8; ++d0) S.qr[d0] = load8<TIn>(nxt.Q + (size_t)(widb * QBLK + r32b) * D + d0 * 16 + hib * 8); }
    SBAR();
    finishSM(pA0, pA1, alA, l_reg, pa0, pa1, pa2, pa3); SBAR();
    if constexpr (F32) {
#pragma unroll
        for (int e = 8; e < 16; ++e) S.tq[e] = *(const f32x4*)QROW(e); SBAR(); }
#undef QROW
    pv_tile<0, SK>(o, vb0, pa0, pa1, pa2, pa3, ACT(even ? NT - 2 : NT - 1));
    if (even) { MASKT(pB0, pB1, NT - 1); partialSM(pB0, pB1, m_reg, mnB, alB); __syncthreads(); RESC(alB);
        finishSM(pB0, pB1, alB, l_reg, pa0, pa1, pa2, pa3); SBAR(); pv_tile<1, SK>(o, vb0, pa0, pa1, pa2, pa3, ACT(NT - 1)); }
    SBAR(); SEAM_K0();
    float* li_b = (float*)(lds + 2 * SHM_V + 2 * SHM_K) + widb * 64;
    if (hib == 0) li_b[r32b] = l_reg; asm volatile("s_waitcnt lgkmcnt(0)" ::: "memory");
    float rli[16];
#pragma unroll
    for (int r = 0; r < 16; ++r) rli[r] = __builtin_amdgcn_rcpf(li_b[crow(r, hib)]);
    {
        typedef __attribute__((address_space(3))) unsigned short lus; typedef __attribute__((address_space(3))) u32x4 lu4;
        const unsigned ost = (unsigned)(uintptr_t)lds + OST_OFF + widb * 8192;
#pragma unroll
        for (int r = 0; r < 16; ++r) { const int orow = crow(r, hib);
#pragma unroll
            for (int d0 = 0; d0 < 4; ++d0) { const float v = o[d0][r] * rli[r]; const unsigned w = cvtpk(v, v);
                *(lus*)(ost + orow * 256 + (d0 * 32 + r32b) * 2) = (unsigned short)w; } }
        asm volatile("s_waitcnt lgkmcnt(0)" ::: "memory");
        TOut* Ow = cur.O + (size_t)(widb * QBLK) * OP; const char* Gw = (const char*)Ow + gdelta;
#pragma unroll
        for (int half = 0; half < 2; ++half) { u32x4 ov[4], gv[4];
#pragma unroll
            for (int i = 0; i < 4; ++i) { const int ci = laneb + 64 * (4 * half + i), row = ci >> 4, ch = ci & 15; ov[i] = *(const lu4*)(ost + row * 256 + ch * 16); gv[i] = *(const u32x4*)(Gw + ((size_t)row * OP + ch * 8) * 2); }
#pragma unroll
            for (int i = 0; i < 4; ++i) { const int ci = laneb + 64 * (4 * half + i), row = ci >> 4, ch = ci & 15; u32x4 w;
#pragma unroll
                for (int e = 0; e < 4; ++e) { const float a0 = __uint_as_float(ov[i][e] << 16) * __uint_as_float(gv[i][e] << 16), a1 = __uint_as_float(ov[i][e] & 0xffff0000u) * __uint_as_float(gv[i][e] & 0xffff0000u); w[e] = cvtpk(a0, a1); }
                *(u32x4*)((char*)Ow + ((size_t)row * OP + ch * 8) * 2) = w; } }
    }
    if constexpr (F32) {
#pragma unroll
        for (int d0 = 0; d0 < 8; ++d0) S.qr[d0] = pack8(S.tq[2 * d0], S.tq[2 * d0 + 1]); }
    __syncthreads();
#undef RESC
#undef KBASE
#undef ACT
#undef MASKT
#undef SEAM_K0
#undef HALF_STEP
}
#undef ROW
#undef VMW
#undef VMWN
#undef SLOAD_H
#undef SWRITE_HK
#undef SWRITE_HV
#undef SWRITE_H
#undef SLOAD_F
#undef SWRITE_KF
#undef SWRITE_VF

__host__ __device__ inline int swa_nramp(int nqb, int W, int qoff) { const int t = W - 1 - qoff; const int n = t < 0 ? 0 : t / QB + 1; return n > nqb ? nqb : n; }
__host__ __device__ inline int swa_nx(int nqb, int nramp, int order) { return (order & ORDER_PAIRED) ? (nramp + 1) / 2 + (nqb - nramp) : nqb; }
struct SwaItem { int bh, qb0, qb1; };
__device__ __forceinline__ SwaItem swa_decode(int L, int nqb, int nx, int nramp) {
    SwaItem it; it.bh = L / nx; const int x = L - it.bh * nx; const int ns = nqb - nramp;
    if (x < ns) { it.qb0 = it.qb1 = nqb - 1 - x; } else { it.qb0 = x - ns; it.qb1 = nramp - 1 - it.qb0; }
    return it;
}
}
constexpr int NWAVES = 8;
#ifndef MK_N_LAUNCHES
#define MK_N_LAUNCHES 1
#endif
constexpr int DM = 2048, NBATCH = 4, SEQ = 4096, M = NBATCH * SEQ, DEPTH = 4, HD = 128, DH = 1024, EVEN_IN = 8192, ODD_IN = 8208, NFOX = 16, DFF = 5504, DFF2 = 2 * DFF;
constexpr int NUNITS = 64 * 64;
constexpr size_t MiB = 1u << 20;
constexpr size_t WS_CTL = 0, CTL_ZERO_BYTES = 1 * MiB;
constexpr size_t WS_RSP = 2 * MiB;
constexpr size_t WS_LF = 4 * MiB;
constexpr size_t WS_DEC = 5 * MiB;
constexpr size_t WS_WF = 7 * MiB;
constexpr size_t WS_WIE = 8 * MiB, WS_WOE = 72 * MiB, WS_WIO = 88 * MiB, WS_WOO = 152 * MiB, WS_WU = 168 * MiB, WS_WD = 340 * MiB;
constexpr size_t WS_XB = 426 * MiB;
constexpr size_t WS_OB = 490 * MiB;
constexpr size_t WS_PROJ = 554 * MiB;
constexpr size_t WS_KV = WS_PROJ + 256 * MiB;
constexpr size_t WS_ACT = 898 * MiB;
constexpr size_t WS_LOGF = 1070 * MiB;
constexpr size_t WS_ST = 1134 * MiB;
constexpr size_t WS_SB = 1262 * MiB;
constexpr size_t WS_END = 1274 * MiB;
static_assert(WS_WD + 4 * (size_t)DM * DFF * 2 <= WS_XB && WS_PROJ + (size_t)M * DFF2 * 2 <= WS_ACT && WS_KV + (size_t)NUNITS * 16384 * 4 <= WS_LOGF && WS_ACT + (size_t)M * DFF * 2 <= WS_LOGF, "ws map");
constexpr int CW_TMO = 0, CW_BAR = 4096, CW_NRM = 8192, CW_CONVQ = 9216  ;
constexpr int RING_BYTES = 131072, CS_OFF = fox::OST_OFF + fox::OST_BYTES  , CS_BYTES = 16384 + 64, MISC_OFF = CS_OFF + CS_BYTES, LDS_BYTES = MISC_OFF + 448;
static_assert(CS_OFF >= RING_BYTES, "lds map");
static_assert(LDS_BYTES <= 160 * 1024 && LDS_BYTES > 80 * 1024, "one workgroup per CU");

#define GAS __attribute__((address_space(1)))
#define LAS __attribute__((address_space(3)))
typedef unsigned short bf16;
typedef unsigned v4u __attribute__((ext_vector_type(4)));
typedef unsigned v2u __attribute__((ext_vector_type(2)));
typedef float f32x4 __attribute__((ext_vector_type(4)));
typedef float f32x2 __attribute__((ext_vector_type(2)));
typedef short bf16x8 __attribute__((ext_vector_type(8)));
#define LDS_WAIT() asm volatile("s_waitcnt lgkmcnt(0)" ::: "memory")
#define VM_WAIT() asm volatile("s_waitcnt vmcnt(0)" ::: "memory")
__device__ __forceinline__ unsigned f2bf(float f) { unsigned u = __builtin_bit_cast(unsigned, f); return (u + 0x7fffu + ((u >> 16) & 1u)) >> 16; }
__device__ __forceinline__ unsigned pk2(float lo, float hi) { return pg8::cvt_pk_bf16_c(lo, hi); }
__device__ __forceinline__ float bf2f(unsigned short b) { return __builtin_bit_cast(float, (unsigned)b << 16); }
__device__ __forceinline__ float bflo(unsigned w) { return __builtin_bit_cast(float, w << 16); }
__device__ __forceinline__ float bfhi(unsigned w) { return __builtin_bit_cast(float, w & 0xffff0000u); }
__device__ __forceinline__ float wave_sum(float v) {
    const int l_ = pg8::lane_now();
#pragma unroll
    for (int o = 1; o < 64; o <<= 1) v += pg8::shfl_xor_l(v, o, l_);
    return v;
}
#define XB_TMO      128
#define XB_XCNT(j)  (256  + 64 * (j))
#define XB_XSUB(j)  (1280 + 64 * (j))
#define XB_XGEN(j)  (2304 + 64 * (j))
#define XB_TOP      3328
#define XB_TOPGEN   3392
#define XCD_BAR_WORDS 3456
#define XB_SPIN_CAP (1u << 18)

__device__ __forceinline__ unsigned xb_ld(unsigned* p)              { return __hip_atomic_load(p, __ATOMIC_RELAXED, __HIP_MEMORY_SCOPE_AGENT); }
__device__ __forceinline__ unsigned xb_add(unsigned* p, unsigned v) { return __hip_atomic_fetch_add(p, v, __ATOMIC_RELAXED, __HIP_MEMORY_SCOPE_AGENT); }
__device__ __forceinline__ unsigned xb_xcc_id() { return (unsigned)__builtin_amdgcn_s_getreg((3 << 11) | 20) & 0xFu; }
#define XB_SPIN(cond, bar) do { unsigned _sp = 0; while (cond) { __builtin_amdgcn_s_sleep(1); \
    if ((++_sp & 255u) == 0u) { if (xb_ld(&(bar)[XB_TMO])) break; if (_sp > XB_SPIN_CAP) { atomicAdd(&(bar)[XB_TMO], 1u); break; } } } } while (0)

struct XcdBarrier {
    unsigned* bar; unsigned x;
    volatile LAS unsigned* st;
};

__device__ __forceinline__ XcdBarrier xcd_barrier_post(unsigned* bar, volatile LAS unsigned* st) {
    XcdBarrier b; b.bar = bar; b.x = xb_xcc_id(); b.st = st;
    if (threadIdx.x == 0) (void)xb_add(&bar[XB_XCNT(b.x)], 1u);
    return b;
}
__device__ __forceinline__ void xcd_barrier_complete(unsigned* bar, unsigned x, unsigned& nloc, unsigned& nx) {
    const unsigned G = gridDim.x * gridDim.y * gridDim.z;
    unsigned sum, cnt, mine, sp = 0u;
    for (;;) {
        sum = 0u; cnt = 0u; mine = 0u;
#pragma unroll
        for (unsigned j = 0; j < 16; ++j) { const unsigned c = xb_ld(&bar[XB_XCNT(j)]); sum += c; cnt += (c > 0u) ? 1u : 0u; mine = (j == x) ? c : mine; }
        if (sum == G) break;
        __builtin_amdgcn_s_sleep(1);
        if ((++sp & 255u) == 0u) { if (xb_ld(&bar[XB_TMO])) break; if (sp > XB_SPIN_CAP) { atomicAdd(&bar[XB_TMO], 1u); break; } }
    }
    nloc = mine > 0u ? mine : 1u; nx = cnt > 0u ? cnt : 1u;
}

__device__ __forceinline__ void xcd_barrier(const XcdBarrier& b) {
    asm volatile("s_waitcnt vmcnt(0)" ::: "memory");
    __syncthreads();
    if (threadIdx.x == 0) {
        unsigned* bar = b.bar;
        __builtin_amdgcn_s_waitcnt(0);
        unsigned nloc = b.st[0], nx = b.st[1];
        if (nloc == 0u) { xcd_barrier_complete(bar, b.x, nloc, nx); b.st[0] = nloc; b.st[1] = nx; }
        const unsigned old = xb_add(&bar[XB_XSUB(b.x)], 1u);
        const unsigned gen = old / nloc;
        if (old + 1u == (gen + 1u) * nloc) {
            __builtin_amdgcn_fence(__ATOMIC_RELEASE, "agent");
            asm volatile("s_waitcnt vmcnt(0)" ::: "memory");
            const unsigned og = xb_add(&bar[XB_TOP], 1u);
            const unsigned tg = og / nx;
            if (og + 1u == (tg + 1u) * nx) xb_add(&bar[XB_TOPGEN], 1u);
            else XB_SPIN(xb_ld(&bar[XB_TOPGEN]) == tg, bar);
            __builtin_amdgcn_fence(__ATOMIC_ACQUIRE, "agent");
            xb_add(&bar[XB_XGEN(b.x)], 1u);
            asm volatile("s_waitcnt vmcnt(0)" ::: "memory");
        } else {
            XB_SPIN(xb_ld(&bar[XB_XGEN(b.x)]) == gen, bar);
            __builtin_amdgcn_fence(__ATOMIC_ACQUIRE, "agent");
            asm volatile("s_waitcnt vmcnt(0)" ::: "memory");
        }
    }
    __syncthreads();
}
struct Ctx { LAS unsigned char* lds; int tid, lane, wave, vcu, G, bx; };

__device__ __forceinline__ int src_col(int n, int mode) {
    if (mode == 1 && (n >> 10) >= 4 && (n >> 10) <= 5) { const int p = n & 127; return (n & ~127) + (p >> 1) + 64 * (p & 1); }
    if (mode == 2) return ((n >> 7) & 1) * DFF + (n >> 8) * 128 + (n & 127);
    return n;
}
template <bool NT = false, int KB = 64>
__device__ __forceinline__ void transpose_item(const float* W, int ldw, int K, int N, const float* nw, int mode, bf16* WT, LAS float* scr, int item, int lane) {
    const int nblk = N / 32, kb = item / nblk, nb = item - kb * nblk, k0 = KB * kb, n0 = 32 * nb;
    const int sc = src_col(n0 + (lane & 31), mode);
    float wv[KB / 2];
#pragma unroll
    for (int i = 0; i < KB / 2; ++i) { const float* p_ = W + (size_t)(k0 + 2 * i + (lane >> 5)) * ldw + sc; wv[i] = NT ? __builtin_nontemporal_load(p_) : *p_; }
    if (nw) {
#pragma unroll
        for (int i = 0; i < KB / 2; ++i) wv[i] *= nw[k0 + 2 * i + (lane >> 5)]; }
#pragma unroll
    for (int i = 0; i < KB / 2; ++i) scr[(2 * i + (lane >> 5)) * 33 + (lane & 31)] = wv[i];
    LDS_WAIT(); asm volatile("" ::: "memory");
    const int c = lane & 7;
#pragma unroll
    for (int kk = 0; kk < KB / 64; ++kk)
#pragma unroll
        for (int j = 0; j < 4; ++j) { const int n = (lane >> 3) + 8 * j; const LAS float* s = scr + (64 * kk + 8 * c) * 33 + n;
            v4u o; o.x = pk2(s[0 * 33], s[1 * 33]); o.y = pk2(s[2 * 33], s[3 * 33]); o.z = pk2(s[4 * 33], s[5 * 33]); o.w = pk2(s[6 * 33], s[7 * 33]);
            bf16* dst = WT + (size_t)(n0 + n) * K + k0 + 64 * kk + 8 * c;
            if (NT) __builtin_nontemporal_store(o, (GAS v4u*)dst); else *(GAS v4u*)dst = o; }
    LDS_WAIT(); asm volatile("" ::: "memory");
}
__device__ __forceinline__ void p0_prologue(const Ctx& C, const float* const* in, unsigned char* ws, float* rs0) {
    LAS float* scr = (LAS float*)(C.lds + C.wave * 16384);
    const int gw = C.vcu * NWAVES + C.wave, NGW = C.G * NWAVES;
    int start = gw;
#define TR(Wp, ldw, K, N, nwp, mode, WTp) do { const int nit_ = ((K) / 64) * ((N) / 32); int it_ = start; for (; it_ < nit_; it_ += NGW) transpose_item(Wp, ldw, K, N, nwp, mode, WTp, scr, it_, C.lane); start = it_ - nit_; } while (0)
    TR(in[4], EVEN_IN, DM, EVEN_IN, in[1], 1, (bf16*)(ws + WS_WIE));
    TR(in[8], DM, DM, DM, (const float*)nullptr, 0, (bf16*)(ws + WS_WOE));
    for (int l = 0; l < 2; ++l) {
        TR(in[12] + (size_t)l * DM * DFF2, DFF2, DM, DFF2, in[2] + l * DM, 2, (bf16*)(ws + WS_WU) + (size_t)l * DFF2 * DM);
        TR(in[14] + (size_t)l * DFF * DM, DM, DFF, DM, (const float*)nullptr, 0, (bf16*)(ws + WS_WD) + (size_t)l * DM * DFF);
    }
#undef TR
    { bf16* WF = (bf16*)(ws + WS_WF);
      for (int i = C.vcu * 512 + C.tid; i < 2 * 16 * DM; i += C.G * 512) { const int j = i >> 15, o = (i >> 11) & 15, k = i & 2047;
          WF[i] = (bf16)f2bf(in[9][((size_t)j * DM + k) * ODD_IN + 8192 + o] * in[1][(2 * j + 1) * DM + k]); } }
    { const float* x = in[0]; bf16* XB = (bf16*)(ws + WS_XB);
      for (int m = gw; m < M; m += NGW) { const GAS f32x4* xr = (const GAS f32x4*)(x + (size_t)m * DM) + C.lane; GAS v2u* o8 = (GAS v2u*)(XB + (size_t)m * DM) + C.lane; float s = 0.f;
#pragma unroll
          for (int q = 0; q < 8; ++q) { const f32x4 v = xr[64 * q]; s += (v.x * v.x + v.y * v.y) + (v.z * v.z + v.w * v.w); v2u w; w.x = pk2(v.x, v.y); w.y = pk2(v.z, v.w); o8[64 * q] = w; }
          s = wave_sum(s); if (C.lane < 32) rs0[(size_t)m * 32 + C.lane] = C.lane == 0 ? s : 0.f; } }
}
__device__ __forceinline__ void prep_rstd(const Ctx& C, const float* rs, int pm0, LAS float* tab) {
    if (C.tid < 256) { const float* p = rs + ((size_t)pm0 * 256 + C.tid) * 32; float s = 0.f;
#pragma unroll
        for (int q = 0; q < 8; ++q) { const f32x4 v = *(const GAS f32x4*)(p + 4 * q); s += (v[0] + v[1]) + (v[2] + v[3]); }
        tab[C.tid] = __builtin_amdgcn_rsqf(s * (1.0f / (float)DM) + 1e-6f); }
    __syncthreads();
}
__device__ __forceinline__ void final_norm(const Ctx& C, const bf16* xb, float* out, const float* rs, const float* w) {
    const int gw = C.vcu * NWAVES + C.wave, NGW = C.G * NWAVES;
    for (int m = gw; m < M; m += NGW) { const GAS v2u* xr = (const GAS v2u*)(xb + (size_t)m * DM) + C.lane; GAS f32x4* orow = (GAS f32x4*)(out + (size_t)m * DM) + C.lane; const GAS f32x4* wr = (const GAS f32x4*)w + C.lane;
        const float rstd = __builtin_amdgcn_rsqf(wave_sum(C.lane < 32 ? rs[(size_t)m * 32 + C.lane] : 0.f) * (1.0f / (float)DM) + 1e-6f);
#pragma unroll
        for (int q = 0; q < 8; ++q) { const v2u x = xr[64 * q]; const f32x4 g = wr[64 * q]; orow[64 * q] = (f32x4){bflo(x.x) * rstd * g[0], bfhi(x.x) * rstd * g[1], bflo(x.y) * rstd * g[2], bfhi(x.y) * rstd * g[3]}; } }
}
__device__ __forceinline__ void flogit_phase(const Ctx& C, const bf16* xb, const bf16* wf, const float* rs, const float* bfv, float* lf) {
    const int fr = C.lane & 15, fq = C.lane >> 4, tw = C.wave >> 1, kh = C.wave & 1;
    LAS f32x4* red = (LAS f32x4*)C.lds;
    for (int tile = tw * C.G + C.vcu; tile < M / 16; tile += (NWAVES / 2) * C.G) {
        const GAS bf16x8* ap = (const GAS bf16x8*)(xb + (size_t)(tile * 16 + fr) * DM + kh * (DM / 2) + fq * 8); const GAS bf16x8* bp = (const GAS bf16x8*)(wf + (size_t)fr * DM + kh * (DM / 2) + fq * 8);
        f32x4 acc = {0.f, 0.f, 0.f, 0.f};
#pragma unroll 16
        for (int ks = 0; ks < DM / 64; ++ks) acc = __builtin_amdgcn_mfma_f32_16x16x32_bf16(ap[ks * 4], bp[ks * 4], acc, 0, 0, 0);
        __syncthreads();
        if (kh) red[tw * 64 + C.lane] = acc;
        __syncthreads();
        if (!kh) { acc += red[tw * 64 + C.lane];
            const float bias = bfv[fr];
#pragma unroll
            for (int r = 0; r < 4; ++r) { const int row = tile * 16 + 4 * fq + r; float ss = 0.f;
#pragma unroll
                for (int q = 0; q < 8; ++q) { const f32x4 p = *(const GAS f32x4*)(rs + (size_t)row * 32 + 4 * q); ss += (p[0] + p[1]) + (p[2] + p[3]); }
                const float v = acc[r] * __builtin_amdgcn_rsqf(ss * (1.0f / (float)DM) + 1e-6f) + bias;
                lf[(size_t)row * 16 + fr] = fminf(v, 0.f) - __logf(1.f + __expf(-fabsf(v))); } }
    }
}
__device__ __forceinline__ void unpack8(const v4u w, float (&f)[8]) { f[0] = bflo(w.x); f[1] = bfhi(w.x); f[2] = bflo(w.y); f[3] = bfhi(w.y); f[4] = bflo(w.z); f[5] = bfhi(w.z); f[6] = bflo(w.w); f[7] = bfhi(w.w); }
__device__ __forceinline__ void conv_fix(const Ctx& C, const float* sb, const float* cw, bf16* ACT) {
    constexpr int NCG = DFF / 8;
    for (int it = C.vcu * 512 + C.tid; it < 63 * NCG; it += C.G * 512) {
        const int pmi = it / NCG + 1, cg = it - (pmi - 1) * NCG, c0 = cg * 8, pn = c0 >> 7, w = c0 & 127;
        if ((pmi & 15) == 0) continue;
        float ug[4][8], uv[4][8];
#pragma unroll
        for (int r = 0; r < 4; ++r) { const float* sp = sb + (size_t)(r < 2 ? (pmi - 1) * 4 + 2 + r : pmi * 4 + (r - 2)) * DFF2 + pn * 256 + w;
            const f32x4 a = *(const GAS f32x4*)sp, b = *(const GAS f32x4*)(sp + 4), c = *(const GAS f32x4*)(sp + 128), d = *(const GAS f32x4*)(sp + 132);
#pragma unroll
            for (int e = 0; e < 4; ++e) { ug[r][e] = a[e]; ug[r][4 + e] = b[e]; uv[r][e] = c[e]; uv[r][4 + e] = d[e]; } }
        float o0[8], o1[8];
#pragma unroll
        for (int e = 0; e < 8; ++e) { const float g0w = cw[c0 + e], g1w = cw[DFF2 + c0 + e], g2w = cw[2 * DFF2 + c0 + e], v0w = cw[DFF + c0 + e], v1w = cw[DFF2 + DFF + c0 + e], v2w = cw[2 * DFF2 + DFF + c0 + e];
            const float ga = g0w * ug[0][e] + g1w * ug[1][e] + g2w * ug[2][e], va = v0w * uv[0][e] + v1w * uv[1][e] + v2w * uv[2][e];
            const float gb = g0w * ug[1][e] + g1w * ug[2][e] + g2w * ug[3][e], vb = v0w * uv[1][e] + v1w * uv[2][e] + v2w * uv[3][e];
            o0[e] = ga * pg8::fsigmoid(ga) * va; o1[e] = gb * pg8::fsigmoid(gb) * vb; }
        *(GAS v4u*)(ACT + (size_t)(pmi * 256) * DFF + c0) = pg8::pack8f(o0); *(GAS v4u*)(ACT + (size_t)(pmi * 256 + 1) * DFF + c0) = pg8::pack8f(o1);
    }
}
#define LBAR() asm volatile("s_waitcnt lgkmcnt(0)\n\ts_barrier" ::: "memory")
__device__ __forceinline__ void tile_ld(v4u (&r)[2], const bf16* src, int tid) {
#pragma unroll
    for (int i = 0; i < 2; ++i) r[i] = *(const GAS v4u*)(src + (size_t)(tid + 512 * i) * 8);
}
__device__ __forceinline__ void tile_st(LAS unsigned char* dst, const v4u (&r)[2], int tid) {
#pragma unroll
    for (int i = 0; i < 2; ++i) { const int idx = tid + 512 * i; *(LAS v4u*)(dst + (idx >> 4) * 272 + (idx & 15) * 16) = r[i]; }
}
typedef _Float16 lf16;
__device__ __forceinline__ void lf_ld(unsigned (&lf)[16], const lf16* lft, int c, int sg) {
#pragma unroll
    for (int i = 0; i < 16; ++i) lf[i] = *(const GAS unsigned short*)((const unsigned short*)lft + (16 * sg + i) * 128 + c);
}
__device__ __forceinline__ float lf_cv(unsigned w) { return (float)__builtin_bit_cast(lf16, (unsigned short)w); }
__device__ __forceinline__ void chunk_cumsum(float (&b)[16], float& blast, float& bmid, LAS float* segsum, int c, int sg) {
#pragma unroll
    for (int i = 1; i < 16; ++i) b[i] += b[i - 1];
    segsum[sg * 128 + c] = b[15];
    LBAR();
    const float s0 = segsum[c], s1 = segsum[128 + c], s2 = segsum[256 + c], s3 = segsum[384 + c];
    const float off = sg == 0 ? 0.f : (sg == 1 ? s0 : (sg == 2 ? s0 + s1 : s0 + s1 + s2));
#pragma unroll
    for (int i = 0; i < 16; ++i) b[i] += off;
    bmid = s0 + s1; blast = (s0 + s1) + (s2 + s3);
}
#define LFRAG(base, pitch, row, kk) (*(const LAS bf16x8*)((base) + (row) * (pitch) + (kk) * 2))
struct EUnit { int ret, h, hh; size_t m0, hoff; };
__device__ __forceinline__ EUnit e_unit(int unit) { EUnit u; const int chain = unit >> 6, n = unit & 63, b = chain >> 4; u.hh = chain & 15; u.ret = u.hh >> 3; u.h = u.hh & 7; u.m0 = (size_t)b * SEQ + n * 64; u.hoff = ((size_t)u.h * M + u.m0) * 128; return u; }
__device__ __forceinline__ void even_ea(const Ctx& C, const bf16* proj, const lf16* logf, float* SUMKV, float* SUMD) {
    LAS unsigned char* L = C.lds;
    constexpr int O_KRAW = 0, O_VRAW = 17408, O_KT = 34816, O_VT = 53248, O_SS = 71680, O_DEC = 73728;
    const int c = C.tid & 127, sg = C.tid >> 7, fr = C.lane & 15, fq = C.lane >> 4;
    for (int cq = C.vcu; cq < 256; cq += C.G) {
        const int unit0 = (cq >> 2) * 64 + (cq & 3) * 16;
        f32x4 acc[8];
#pragma unroll
        for (int tn = 0; tn < 8; ++tn) acc[tn] = (f32x4){0.f, 0.f, 0.f, 0.f};
        float bltot = 0.f;
        v4u rk[2], rv[2]; unsigned lf[16];
        { const EUnit u = e_unit(unit0); if (u.ret) tile_ld(rk, proj + (size_t)5 * M * 1024 + u.hoff, C.tid); tile_ld(rv, proj + (size_t)(u.ret ? 6 : 2) * M * 1024 + u.hoff, C.tid); if (!u.ret) lf_ld(lf, logf + u.hoff, c, sg); }
#pragma unroll 1
        for (int i = 0; i < 16; ++i) {
            const EUnit u = e_unit(unit0 + i);
            if (u.ret) tile_st(L + O_KRAW, rk, C.tid);
            tile_st(L + O_VRAW, rv, C.tid);
            float bc[16], blast, bmid; const float lg = log1pf(-exp2f(-5.f - (float)u.h));
#pragma unroll
            for (int q = 0; q < 16; ++q) bc[q] = u.ret ? lg : lf_cv(lf[q]);
            float kk[16];
#pragma unroll
            for (int q = 0; q < 16; ++q) kk[q] = u.ret ? 0.f : 1.f - __expf(bc[q]);
            if (i + 1 < 16) { const EUnit v = e_unit(unit0 + i + 1); if (v.ret) tile_ld(rk, proj + (size_t)5 * M * 1024 + v.hoff, C.tid); tile_ld(rv, proj + (size_t)(v.ret ? 6 : 2) * M * 1024 + v.hoff, C.tid); if (!v.ret) lf_ld(lf, logf + v.hoff, c, sg); }
            chunk_cumsum(bc, blast, bmid, (LAS float*)(L + O_SS), c, sg);
            unsigned kw[8], vw[8];
#pragma unroll
            for (int q = 0; q < 8; ++q) { const int t0 = 16 * sg + 2 * q;
                float k0 = kk[2 * q], k1 = kk[2 * q + 1];
                if (u.ret) { k0 = bf2f(*(const LAS unsigned short*)(L + O_KRAW + t0 * 272 + c * 2)); k1 = bf2f(*(const LAS unsigned short*)(L + O_KRAW + (t0 + 1) * 272 + c * 2)); }
                const unsigned short v0 = *(const LAS unsigned short*)(L + O_VRAW + t0 * 272 + c * 2), v1 = *(const LAS unsigned short*)(L + O_VRAW + (t0 + 1) * 272 + c * 2);
                kw[q] = pk2(k0 * __expf(fmaxf(blast - bc[2 * q], -80.f)), k1 * __expf(fmaxf(blast - bc[2 * q + 1], -80.f)));
                vw[q] = (unsigned)v0 | ((unsigned)v1 << 16); }
            *(LAS v4u*)(L + O_KT + c * 144 + sg * 32) = (v4u){kw[0], kw[1], kw[2], kw[3]}; *(LAS v4u*)(L + O_KT + c * 144 + sg * 32 + 16) = (v4u){kw[4], kw[5], kw[6], kw[7]};
            *(LAS v4u*)(L + O_VT + c * 144 + sg * 32) = (v4u){vw[0], vw[1], vw[2], vw[3]}; *(LAS v4u*)(L + O_VT + c * 144 + sg * 32 + 16) = (v4u){vw[4], vw[5], vw[6], vw[7]};
            if (sg == 0) ((LAS float*)(L + O_DEC))[c] = __expf(fmaxf(blast, -80.f));
            bltot += blast;
            LBAR();
            const f32x4 dec4 = *(const LAS f32x4*)(L + O_DEC + (16 * C.wave + 4 * fq) * 4);
#pragma unroll
            for (int tn = 0; tn < 8; ++tn) acc[tn] = acc[tn] * dec4;
#pragma unroll
            for (int ks = 0; ks < 2; ++ks) { const bf16x8 a = LFRAG(L + O_KT, 144, 16 * C.wave + fr, 32 * ks + 8 * fq);
#pragma unroll
                for (int tn = 0; tn < 8; ++tn) acc[tn] = __builtin_amdgcn_mfma_f32_16x16x32_bf16(a, LFRAG(L + O_VT, 144, 16 * tn + fr, 32 * ks + 8 * fq), acc[tn], 0, 0, 0); }
            LBAR();
        }
        float* kvp = SUMKV + (size_t)cq * 16384 + 16 * C.wave + 4 * fq;
#pragma unroll
        for (int tn = 0; tn < 8; ++tn) *(GAS f32x4*)(kvp + (16 * tn + fr) * 128) = acc[tn];
        if (sg == 0) SUMD[(size_t)cq * 128 + c] = __expf(fmaxf(bltot, -80.f));
    }
}
template <int VAR>
__device__ __forceinline__ void even_eb(const Ctx& C, const bf16* proj, const lf16* logf, const float* SUMKV, const float* SUMD, const float* nw_h, const float* nw_r, bf16* OB) {
    LAS unsigned char* L = C.lds;
    constexpr int O_Q = 0, O_K = 17408, O_QH = 34816, O_VRAW = 52224, O_VT = 69632, O_ST = 88064, O_SS = 122880, O_DEC = 124928, O_KT = 125440, O_P = O_VRAW, O_OB = 0;
    static_assert(O_KT + 128 * 144 <= CS_OFF + CS_BYTES, "lds map (EB)");
    const int c = C.tid & 127, sg = C.tid >> 7;
    for (int cq = C.vcu; cq < 256; cq += C.G) {
        const int chain = cq >> 2, qd = cq & 3, unit0 = chain * 64 + qd * 16;
        int fr = C.lane & 15, fq = C.lane >> 4;
        f32x4 S[8];
#pragma unroll
        for (int tn = 0; tn < 8; ++tn) S[tn] = (f32x4){0.f, 0.f, 0.f, 0.f};
        for (int qp = 0; qp < qd; ++qp) { const size_t cp = (size_t)(chain * 4 + qp);
            const f32x4 d4 = *(const GAS f32x4*)(SUMD + cp * 128 + 16 * C.wave + 4 * fq);
#pragma unroll
            for (int tn = 0; tn < 8; ++tn) S[tn] = S[tn] * d4 + *(const GAS f32x4*)(SUMKV + cp * 16384 + (16 * tn + fr) * 128 + 16 * C.wave + 4 * fq); }
#pragma unroll
        for (int tn = 0; tn < 8; ++tn) *(LAS v2u*)(L + O_ST + (16 * tn + fr) * 272 + (16 * C.wave + 4 * fq) * 2) = (v2u){pk2(S[tn][0], S[tn][1]), pk2(S[tn][2], S[tn][3])};
        f32x4 nwv[4];
        { const EUnit u0 = e_unit(unit0); const float* nw = (u0.ret ? nw_r : nw_h) + u0.h * 128 + (C.tid & 7) * 16;
#pragma unroll
          for (int q4 = 0; q4 < 4; ++q4) nwv[q4] = *(const GAS f32x4*)(nw + 4 * q4); }
        v4u rq[2][2], rk[2][2], rv[2][2], rg[2][2]; unsigned lf[2][16];
        auto pref = [&](v4u (&q_)[2], v4u (&k_)[2], v4u (&v_)[2], v4u (&g_)[2], unsigned (&lf_)[16], const int un) __attribute__((always_inline)) {
            const EUnit w_ = e_unit(un); tile_ld(q_, proj + (size_t)(w_.ret ? 4 : 0) * M * 1024 + w_.hoff, C.tid); if (w_.ret) tile_ld(k_, proj + (size_t)5 * M * 1024 + w_.hoff, C.tid);
            tile_ld(v_, proj + (size_t)(w_.ret ? 6 : 2) * M * 1024 + w_.hoff, C.tid);
            { const bf16* gp_ = proj + (size_t)(w_.ret ? 7 : 3) * M * 1024 + w_.hoff + (size_t)C.tid * 16; g_[0] = *(const GAS v4u*)gp_; g_[1] = *(const GAS v4u*)(gp_ + 8); }
            if (!w_.ret) lf_ld(lf_, logf + w_.hoff, c, sg); };
        pref(rq[0], rk[0], rv[0], rg[0], lf[0], unit0); pref(rq[1], rk[1], rv[1], rg[1], lf[1], unit0 + 1);
        auto chunk = [&](v4u (&q_)[2], v4u (&k_)[2], v4u (&v_)[2], v4u (&g_)[2], unsigned (&lf_)[16], const int i) __attribute__((always_inline)) {
            const int unit = unit0 + i;
            { int l_ = C.lane; asm volatile("" : "+v"(l_)); fr = l_ & 15; fq = l_ >> 4; }
            const EUnit u = e_unit(unit); const int ret = u.ret, h = u.h, hh = u.hh; const size_t m0 = u.m0;
            tile_st(L + O_Q, q_, C.tid); if (ret) tile_st(L + O_K, k_, C.tid);
            tile_st(L + O_VRAW, v_, C.tid);
            const v4u gp0 = g_[0], gp1 = g_[1];
            float bc[16], blast, bmid; const float lg = log1pf(-exp2f(-5.f - (float)h));
#pragma unroll
            for (int q = 0; q < 16; ++q) bc[q] = ret ? lg : lf_cv(lf_[q]);
            float kk[16];
#pragma unroll
            for (int q = 0; q < 16; ++q) kk[q] = ret ? 0.f : 1.f - __expf(bc[q]);
            if (i + 2 < 16 && !(VAR & 16)) pref(q_, k_, v_, g_, lf_, unit + 2);
            chunk_cumsum(bc, blast, bmid, (LAS float*)(L + O_SS), c, __builtin_amdgcn_readfirstlane(sg));
            unsigned vw[8], kw[8];
            int a0 = 16 * sg * 272 + c * 2; asm volatile("" : "+v"(a0));
            if (!(VAR & 1)) {
            constexpr float L2E = 1.44269504f, CL2 = 115.4f;
            const float bm2 = bmid * L2E;
            const f32x2 E12 = {__builtin_amdgcn_exp2f(fmaxf(bm2, -CL2)), __builtin_amdgcn_exp2f(fmaxf(blast * L2E - bm2, -CL2))};
#pragma unroll
            for (int q8 = 0; q8 < 8; ++q8) { f32x2 sq[2], sh[2];
#pragma unroll
                for (int z = 0; z < 2; ++z) {
                    const float e2 = __builtin_amdgcn_fmed3f(__builtin_fmaf(bc[2 * q8 + z], L2E, -bm2), -CL2, CL2);
                    const float ee = __builtin_amdgcn_exp2f(e2), ei = __builtin_amdgcn_rcpf(ee);
                    float kr_ = kk[2 * q8 + z]; if (ret) kr_ = bf2f(*(const LAS unsigned short*)(L + O_K + a0 + (2 * q8 + z) * 272));
                    const f32x2 qk = {bf2f(*(const LAS unsigned short*)(L + O_Q + a0 + (2 * q8 + z) * 272)), kr_};
                    sq[z] = qk * (f32x2){ee, ei}; sh[z] = sq[z] * E12; }
                const unsigned wq = pk2(sq[0].x, sq[1].x), wk = pk2(sq[0].y, sq[1].y), wh = pk2(sh[0].x, sh[1].x);
                kw[q8] = pk2(sh[0].y, sh[1].y);
                *(LAS unsigned short*)(L + O_Q + a0 + (2 * q8) * 272) = (unsigned short)wq; *(LAS unsigned short*)(L + O_Q + a0 + (2 * q8 + 1) * 272) = (unsigned short)(wq >> 16);
                *(LAS unsigned short*)(L + O_K + a0 + (2 * q8) * 272) = (unsigned short)wk; *(LAS unsigned short*)(L + O_K + a0 + (2 * q8 + 1) * 272) = (unsigned short)(wk >> 16);
                *(LAS unsigned short*)(L + O_QH + a0 + (2 * q8) * 272) = (unsigned short)wh; *(LAS unsigned short*)(L + O_QH + a0 + (2 * q8 + 1) * 272) = (unsigned short)(wh >> 16);
                const unsigned short v0 = *(const LAS unsigned short*)(L + O_VRAW + a0 + (2 * q8) * 272), v1 = *(const LAS unsigned short*)(L + O_VRAW + a0 + (2 * q8 + 1) * 272);
                vw[q8] = (unsigned)v0 | ((unsigned)v1 << 16); }
            *(LAS v4u*)(L + O_VT + c * 144 + sg * 32) = (v4u){vw[0], vw[1], vw[2], vw[3]}; *(LAS v4u*)(L + O_VT + c * 144 + sg * 32 + 16) = (v4u){vw[4], vw[5], vw[6], vw[7]};
            *(LAS v4u*)(L + O_KT + c * 144 + sg * 32) = (v4u){kw[0], kw[1], kw[2], kw[3]}; *(LAS v4u*)(L + O_KT + c * 144 + sg * 32 + 16) = (v4u){kw[4], kw[5], kw[6], kw[7]};
            if (sg == 0) ((LAS float*)(L + O_DEC))[c] = __expf(fmaxf(blast, -80.f));
            }
            LBAR();
            if (!(VAR & 2)) {
            const int tm = C.wave >> 1, t = 16 * tm + fr;
#pragma unroll
            for (int tt = 0; tt < 2; ++tt) { const int tn = 2 * (C.wave & 1) + tt; f32x4 acc = {0.f, 0.f, 0.f, 0.f};
                if (tn <= tm) {
#pragma unroll
                    for (int ks = 0; ks < 4; ++ks) acc = __builtin_amdgcn_mfma_f32_16x16x32_bf16(LFRAG(L + O_K, 272, 16 * tn + fr, 32 * ks + 8 * fq), LFRAG(L + O_Q, 272, t, 32 * ks + 8 * fq), acc, 0, 0, 0); }
                const int s0 = 16 * tn + 4 * fq;
#pragma unroll
                for (int r = 0; r < 4; ++r) if (s0 + r > t) acc[r] = 0.f;
                *(LAS v2u*)(L + O_P + t * 144 + s0 * 2) = (v2u){pk2(acc[0], acc[1]), pk2(acc[2], acc[3])}; }
            LBAR();
            f32x4 o[4]; const int tn0 = 4 * (C.wave & 1);
#pragma unroll
            for (int j = 0; j < 4; ++j) o[j] = (f32x4){0.f, 0.f, 0.f, 0.f};
#pragma unroll
            for (int ks = 0; ks < 2; ++ks) { const bf16x8 a = LFRAG(L + O_P, 144, t, 32 * ks + 8 * fq);
#pragma unroll
                for (int j = 0; j < 4; ++j) o[j] = __builtin_amdgcn_mfma_f32_16x16x32_bf16(LFRAG(L + O_VT, 144, 16 * (tn0 + j) + fr, 32 * ks + 8 * fq), a, o[j], 0, 0, 0); }
#pragma unroll
            for (int ks = 0; ks < 4; ++ks) { const bf16x8 a = LFRAG(L + O_QH, 272, t, 32 * ks + 8 * fq);
#pragma unroll
                for (int j = 0; j < 4; ++j) o[j] = __builtin_amdgcn_mfma_f32_16x16x32_bf16(LFRAG(L + O_ST, 272, 16 * (tn0 + j) + fr, 32 * ks + 8 * fq), a, o[j], 0, 0, 0); }
#pragma unroll
            for (int j = 0; j < 4; ++j) *(LAS f32x4*)(L + O_OB + t * 528 + (16 * (tn0 + j) + 4 * fq) * 4) = o[j];
            LBAR();
            } else { LBAR(); LBAR(); }
            if (!(VAR & 4))
            { const int row = C.tid >> 3, cg = C.tid & 7, ln_ = pg8::lane_now(); f32x2 x2[8];
#pragma unroll
              for (int q4 = 0; q4 < 4; ++q4) { const f32x4 v = *(const LAS f32x4*)(L + O_OB + row * 528 + cg * 64 + q4 * 16); x2[2 * q4] = (f32x2){v[0], v[1]}; x2[2 * q4 + 1] = (f32x2){v[2], v[3]}; }
              float mean = 0.f;
              if (ret) { f32x2 s2 = x2[0];
#pragma unroll
                  for (int e = 1; e < 8; ++e) s2 += x2[e];
                  float s = s2.x + s2.y; s += pg8::shfl_xor_l(s, 1, ln_); s += pg8::shfl_xor_l(s, 2, ln_); s += pg8::shfl_xor_l(s, 4, ln_); mean = s * (1.f / 128.f); }
              const f32x2 m2 = {mean, mean}; f32x2 ss2 = {0.f, 0.f};
#pragma unroll
              for (int e = 0; e < 8; ++e) { x2[e] -= m2; ss2 += x2[e] * x2[e]; }
              float ss = ss2.x + ss2.y; ss += pg8::shfl_xor_l(ss, 1, ln_); ss += pg8::shfl_xor_l(ss, 2, ln_); ss += pg8::shfl_xor_l(ss, 4, ln_);
              const float rstd = __builtin_amdgcn_rsqf(ss * (1.f / 128.f) + 1e-6f); const f32x2 r2 = {rstd, rstd};
              const unsigned gw[8] = {gp0.x, gp0.y, gp0.z, gp0.w, gp1.x, gp1.y, gp1.z, gp1.w};
              unsigned yw[8];
#pragma unroll
              for (int q4 = 0; q4 < 4; ++q4) { const f32x4 w = nwv[q4];
#pragma unroll
                  for (int e = 0; e < 2; ++e) { const f32x2 y = x2[2 * q4 + e] * r2 * (f32x2){w[2 * e], w[2 * e + 1]} * (f32x2){bflo(gw[2 * q4 + e]), bfhi(gw[2 * q4 + e])}; yw[2 * q4 + e] = pk2(y.x, y.y); } }
              bf16* op = OB + (m0 + row) * DM + hh * 128 + cg * 16;
              *(GAS v4u*)op = (v4u){yw[0], yw[1], yw[2], yw[3]}; *(GAS v4u*)(op + 8) = (v4u){yw[4], yw[5], yw[6], yw[7]}; }
            if (!(VAR & 8))
            { const f32x4 dec4 = *(const LAS f32x4*)(L + O_DEC + (16 * C.wave + 4 * fq) * 4);
#pragma unroll
              for (int tn = 0; tn < 8; ++tn) S[tn] = S[tn] * dec4;
#pragma unroll
              for (int ks = 0; ks < 2; ++ks) { const bf16x8 a = LFRAG(L + O_KT, 144, 16 * C.wave + fr, 32 * ks + 8 * fq);
#pragma unroll
                  for (int tn = 0; tn < 8; ++tn) S[tn] = __builtin_amdgcn_mfma_f32_16x16x32_bf16(a, LFRAG(L + O_VT, 144, 16 * tn + fr, 32 * ks + 8 * fq), S[tn], 0, 0, 0); }
#pragma unroll
              for (int tn = 0; tn < 8; ++tn) *(LAS v2u*)(L + O_ST + (16 * tn + fr) * 272 + (16 * C.wave + 4 * fq) * 2) = (v2u){pk2(S[tn][0], S[tn][1]), pk2(S[tn][2], S[tn][3])}; }
            LBAR();
        };
#pragma unroll 1
        for (int i = 0; i < 16; i += 2) { chunk(rq[0], rk[0], rv[0], rg[0], lf[0], i); chunk(rq[1], rk[1], rv[1], rg[1], lf[1], i + 1); }
    }
}
__device__ __forceinline__ void fox_cs(const float* lf, int bh, LAS float* cs, int tid, int lane, int wave) {
    { int t_ = threadIdx.x; asm volatile("" : "+v"(t_)); tid = t_; lane = t_ & 63; wave = __builtin_amdgcn_readfirstlane(t_ >> 6); }
    const int b = bh >> 4, h = bh & 15; const float* base = lf + ((size_t)b * SEQ + tid * 8) * 16 + h; float v[8];
#pragma unroll
    for (int e = 0; e < 8; ++e) v[e] = base[e * 16];
#pragma unroll
    for (int e = 1; e < 8; ++e) v[e] += v[e - 1];
    float x = v[7];
#pragma unroll
    for (int d = 1; d < 64; d <<= 1) { const float y = pg8::shfl_up_l(x, d, lane); if (lane >= d) x += y; }
    if (lane == 63) cs[4096 + wave] = x;
    __syncthreads();
    float off = x - v[7];
    for (int w = 0; w < wave; ++w) off += cs[4096 + w];
#pragma unroll
    for (int e = 0; e < 8; ++e) cs[tid * 8 + e] = (v[e] + off) * -11.313708498984761f;
    __syncthreads();
}
constexpr int CF_KB = 128;
constexpr int CF_IE = (DM / CF_KB) * (EVEN_IN / 32), CF_OO = (DM / CF_KB) * (DM / 32), CF_U = (DM / CF_KB) * (DFF2 / 32), CF_D = (DFF / CF_KB) * (DM / 32);
static_assert(DM % CF_KB == 0 && DFF % CF_KB == 0, "filler item height");
static_assert(CF_IE % 8 == 0 && CF_OO % 8 == 0 && CF_U % 8 == 0 && CF_D % 8 == 0, "eight wave items per claim never straddle two matrices");
__device__ __forceinline__ constexpr int cf_items(int set) { return set == 0 ? CF_IE + CF_U + CF_D : set == 1 ? CF_OO + CF_D : set == 2 ? CF_IE + CF_OO : set == 3 ? CF_IE + CF_OO : CF_U; }
__device__ __forceinline__ void conv_mat(int mat, int i, int r, const float* const* in, unsigned char* ws, LAS float* scr, int lane) {
    if (mat == 0) transpose_item<true, CF_KB>(in[4] + (size_t)i * DM * EVEN_IN, EVEN_IN, DM, EVEN_IN, in[1] + (2 * i) * DM, 1, (bf16*)(ws + WS_WIE) + (size_t)i * EVEN_IN * DM, scr, r, lane);
    else if (mat == 1) transpose_item<true, CF_KB>(in[8] + (size_t)i * DM * DM, DM, DM, DM, (const float*)nullptr, 0, (bf16*)(ws + WS_WOE) + (size_t)i * DM * DM, scr, r, lane);
    else if (mat == 2) transpose_item<true, CF_KB>(in[9] + (size_t)i * DM * ODD_IN, ODD_IN, DM, 8192, in[1] + (2 * i + 1) * DM, 0, (bf16*)(ws + WS_WIO) + (size_t)i * 8192 * DM, scr, r, lane);
    else if (mat == 3) transpose_item<true, CF_KB>(in[11] + (size_t)i * DM * DM, DM, DM, DM, (const float*)nullptr, 0, (bf16*)(ws + WS_WOO) + (size_t)i * DM * DM, scr, r, lane);
    else if (mat == 4) transpose_item<true, CF_KB>(in[12] + (size_t)i * DM * DFF2, DFF2, DM, DFF2, in[2] + i * DM, 2, (bf16*)(ws + WS_WU) + (size_t)i * DFF2 * DM, scr, r, lane);
    else transpose_item<true, CF_KB>(in[14] + (size_t)i * DFF * DM, DM, DFF, DM, (const float*)nullptr, 0, (bf16*)(ws + WS_WD) + (size_t)i * DM * DFF, scr, r, lane);
}
__device__ __forceinline__ void conv_item(int set, int r, const float* const* in, unsigned char* ws, LAS float* scr, int lane) {
    if (set == 0) {
        if (r < CF_IE) { conv_mat(2, 1, r, in, ws, scr, lane); return; } r -= CF_IE;
        if (r < CF_U) { conv_mat(4, 2, r, in, ws, scr, lane); return; } r -= CF_U;
        conv_mat(5, 2, r, in, ws, scr, lane);
    } else if (set == 1) {
        if (r < CF_OO) { conv_mat(3, 1, r, in, ws, scr, lane); return; } r -= CF_OO;
        conv_mat(5, 3, r, in, ws, scr, lane);
    } else if (set == 2) {
        if (r < CF_IE) { conv_mat(2, 0, r, in, ws, scr, lane); return; } r -= CF_IE;
        conv_mat(3, 0, r, in, ws, scr, lane);
    } else if (set == 3) {
        if (r < CF_IE) { conv_mat(0, 1, r, in, ws, scr, lane); return; } r -= CF_IE;
        conv_mat(1, 1, r, in, ws, scr, lane);
    } else conv_mat(4, 3, r, in, ws, scr, lane);
}
__device__ __forceinline__ void conv_filler(int set, const float* const* in, unsigned char* ws, unsigned* queue, LAS unsigned char* ldsb) {
    int t_ = threadIdx.x; asm volatile("" : "+v"(t_)); const int lane = t_ & 63, wave = __builtin_amdgcn_readfirstlane(t_ >> 6);
    const int nclaims = cf_items(set) / 8;
    volatile LAS int* qw = (volatile LAS int*)(ldsb + CS_OFF + 16384 + 32);
    LAS float* scr = (LAS float*)(ldsb + wave * 17408);
    __syncthreads();
    if (t_ == 0) qw[0] = (int)atomicAdd(queue, 1u);
    __syncthreads();
    int cl = qw[0];
    while (cl < nclaims) {
        unsigned nxt = 0u; if (t_ == 0) nxt = atomicAdd(queue, 1u);
        conv_item(set, cl * 8 + wave, in, ws, scr, lane);
        __syncthreads();
        if (t_ == 0) qw[0] = (int)nxt;
        __syncthreads();
        cl = qw[0];
    }
}
typedef fox::BlockRef<__hip_bfloat16, __hip_bfloat16> FoxRef;
__device__ __forceinline__ FoxRef fox_ref(const fox::SwaItem& it, int pass, const bf16* QH, const bf16* KH, const bf16* VH, bf16* OB) {
    const int qb = pass ? it.qb1 : it.qb0, b = it.bh >> 4, hh = it.bh & 15; FoxRef r; r.thr = 0.f;
    r.Q = (const __hip_bfloat16*)(QH + ((size_t)it.bh * SEQ + (size_t)qb * 256) * 128); r.K = (const __hip_bfloat16*)(KH + (size_t)it.bh * SEQ * 128); r.V = (const __hip_bfloat16*)(VH + (size_t)it.bh * SEQ * 128);
    const size_t oo = ((size_t)b * SEQ + (size_t)qb * 256) * DM + hh * 128; r.O = (__hip_bfloat16*)(OB + oo); r.P0 = qb * 256;
    return r;
}
__device__ __forceinline__ float fox_dmin(const bf16* Qb, const bf16* Kb, LAS float* red) {
    int t_ = threadIdx.x; asm volatile("" : "+v"(t_));
    const int row = t_ >> 1, hf = t_ & 1; const GAS v4u* qp = (const GAS v4u*)(Qb + (size_t)row * 128 + hf * 64); const GAS v4u* kp = (const GAS v4u*)(Kb + (size_t)row * 128 + hf * 64);
    v4u q8[8], k8[8];
#pragma unroll
    for (int i = 0; i < 8; ++i) { q8[i] = qp[i]; k8[i] = kp[i]; }
    float d = 0.f;
#pragma unroll
    for (int i = 0; i < 8; ++i) {
#pragma unroll
        for (int e = 0; e < 4; ++e) { d = __builtin_fmaf(bflo(q8[i][e]), bflo(k8[i][e]), d); d = __builtin_fmaf(bfhi(q8[i][e]), bfhi(k8[i][e]), d); } }
    const int ln_ = t_ & 63;
    d += pg8::shfl_xor_l(d, 1, ln_);
#pragma unroll
    for (int o = 2; o < 64; o <<= 1) d = fminf(d, pg8::shfl_xor_l(d, o, ln_));
    __syncthreads();
    if ((t_ & 63) == 0) red[t_ >> 6] = d;
    __syncthreads();
    float m = red[0];
#pragma unroll
    for (int w = 1; w < 8; ++w) m = fminf(m, red[w]);
    return m * 0.08838834764831845f;
}
__device__ __forceinline__ void fox_phase(const Ctx& C, char* lds, const bf16* QH, const bf16* KH, const bf16* VH, const bf16* G, bf16* OB, const float* LF, const unsigned* nrm, const float* bfv) {
    constexpr int nqb = SEQ / 256;
    LAS float* cs = (LAS float*)(C.lds + CS_OFF); const long gdelta = (const char*)G - (const char*)OB;
    int rank = 0;
    { const int my = C.lane & 15; const float bv = bfv[my];
      for (int o = 0; o < 16; ++o) { const float ov = bfv[o]; rank += (ov < bv || (ov == bv && o < my)) ? 1 : 0; } }
    for (int grp = C.vcu; grp < NBATCH * 64; grp += C.G) {
        const int b = grp >> 6, pr = (grp >> 3) & 7, x = grp & 7;
#pragma unroll 1
        for (int half = 0; half < 2; ++half) {
            const int want = half ? pr : 15 - pr;
            const int hh = __builtin_amdgcn_readfirstlane(__builtin_ctzll(__ballot(rank == want && C.lane < 16)));
            fox::SwaItem it; it.bh = b * 16 + hh; it.qb0 = x; it.qb1 = nqb - 1 - x;
            if (half) __syncthreads();
            fox_cs(LF, it.bh, cs, C.tid, C.lane, C.wave);
            float bqk;
            { const unsigned* nq = nrm + (size_t)it.bh * 4; const unsigned* nk = nrm + (size_t)(64 + it.bh) * 4;
              const float q2 = (__uint_as_float(nq[0]) + __uint_as_float(nq[1])) + (__uint_as_float(nq[2]) + __uint_as_float(nq[3])), k2 = (__uint_as_float(nk[0]) + __uint_as_float(nk[1])) + (__uint_as_float(nk[2]) + __uint_as_float(nk[3]));
              bqk = 1.02f * 0.08838834764831845f * sqrtf(q2 * k2); }
            FoxRef r0 = fox_ref(it, 0, QH, KH, VH, OB), r1 = fox_ref(it, 1, QH, KH, VH, OB);
            { const float d0 = fox_dmin((const bf16*)r0.Q, (const bf16*)r0.K + (size_t)r0.P0 * 128, cs + 4104), d1 = fox_dmin((const bf16*)r1.Q, (const bf16*)r1.K + (size_t)r1.P0 * 128, cs + 4104);
              r0.thr = (26.02f + bqk - fminf(d0, bqk)) * 11.313708498984761f; r1.thr = (26.02f + bqk - fminf(d1, bqk)) * 11.313708498984761f; }
            fox::Seam<__hip_bfloat16> S;
            fox::causal_swa_prime<__hip_bfloat16, __hip_bfloat16>(r0, SEQ, lds, S, cs);
            fox::causal_swa_block<__hip_bfloat16, __hip_bfloat16>(r0, r1, SEQ, SEQ, lds, S, cs, gdelta);
            fox::causal_swa_block<__hip_bfloat16, __hip_bfloat16>(r1, r1, SEQ, SEQ, lds, S, cs, gdelta);
        }
    }
}
constexpr int N_PHASES = 28;
struct Args { const float* in[15]; float* out; unsigned char* ws; int ph_lo, ph_hi; };
__global__ void __launch_bounds__(NWAVES * 64, 2) mk_fwd(Args args) {
    extern __shared__ __attribute__((aligned(16))) unsigned char lds[];
    { volatile LAS unsigned* MISC0 = (volatile LAS unsigned*)((LAS unsigned char*)lds + MISC_OFF); if (threadIdx.x < 112) MISC0[threadIdx.x] = 0u; }
    __syncthreads();
    XcdBarrier bar; bar.bar = (unsigned*)(args.ws + WS_CTL) + CW_BAR; bar.x = 0; bar.st = nullptr;
    if (MK_N_LAUNCHES == 1) bar = xcd_barrier_post((unsigned*)(args.ws + WS_CTL) + CW_BAR, (volatile LAS unsigned*)((LAS unsigned char*)lds + MISC_OFF) + 8);
    const int lo = args.ph_lo, hi = args.ph_hi; int ph = 0;
#ifndef PHSEL
#define PHSEL -1
#endif
#ifndef EBVAR
#define EBVAR 0
#endif
#ifndef REPMASK
#define REPMASK 0
#endif
#ifndef NULLEPI
#define NULLEPI 0
#endif
#define PH_BEGIN(k) if (lo <= ph && ph < hi) { for (int rep_ = 0; rep_ <= ((REPMASK >> (k)) & 1); ++rep_) { const bool dry_ = rep_ < ((REPMASK >> (k)) & 1); (void)dry_; Ctx C; { int t_ = threadIdx.x, b_ = blockIdx.x, g_ = gridDim.x; asm volatile("" : "+v"(t_), "+s"(b_), "+s"(g_)); C.lds = (LAS unsigned char*)lds; C.tid = t_; C.lane = t_ & 63; C.wave = __builtin_amdgcn_readfirstlane(t_ >> 6); \
        C.G = g_; C.vcu = (g_ % 8 == 0) ? (b_ % 8) * (g_ / 8) + b_ / 8 : b_; C.bx = b_; } \
    size_t z_ = 0; asm volatile("" : "+s"(z_)); unsigned char* ws = args.ws + z_; float* out = args.out + z_; const float* const* in = args.in;     \
    float* RS = (float*)(ws + WS_RSP); bf16* XB = (bf16*)(ws + WS_XB); bf16* OBF = (bf16*)(ws + WS_OB); bf16* PROJ = (bf16*)(ws + WS_PROJ); bf16* ACT = (bf16*)(ws + WS_ACT); \
    _Float16* LOGF = (_Float16*)(ws + WS_LOGF); bf16* KV = (bf16*)(ws + WS_KV); float* DEC = (float*)(ws + WS_DEC); bf16* ST = (bf16*)(ws + WS_ST); float* LF = (float*)(ws + WS_LF); \
    (void)RS; (void)XB; (void)OBF; (void)PROJ; (void)ACT; (void)LOGF; (void)KV; (void)DEC; (void)ST; (void)LF; (void)in; (void)out;
#define PH_END   if (dry_) { xcd_barrier(bar); } } if (ph + 1 < hi) { xcd_barrier(bar); } } ++ph;

    PH_BEGIN(0) if (PHSEL < 0 || PHSEL == 0) p0_prologue(C, in, ws, RS); PH_END

    for (int l = 0; l < DEPTH; ++l) {
        const int j = l >> 1;
        if ((l & 1) == 0) {
            PH_BEGIN(1) if (PHSEL < 0 || PHSEL == 1) {
                pg8::Gemm g{XB, (const bf16*)(ws + WS_WIE) + (size_t)j * EVEN_IN * DM, M, EVEN_IN, DM}; pg8::StaticOrder S; S.init(M, EVEN_IN, C.G, C.bx);
                pg8::Unit u0; S.next(0, u0); prep_rstd(C, RS, u0.pm, (LAS float*)(C.lds + CS_OFF + 8192));
                pg8::EpiEven E{PROJ, LOGF, pg8::RstdLds{(PG8_LAS float*)(C.lds + CS_OFF + 8192)}, in[5], j};
                if (NULLEPI == 1 && dry_) { pg8::EpiNull EN{(float*)(ws + WS_ST)}; pg8::gemm_phase<pg8::EpiNull, pg8::StaticOrder, true, true>(C.lds, g, S, EN); }
                else pg8::gemm_phase<pg8::EpiEven, pg8::StaticOrder, true, true>(C.lds, g, S, E); } PH_END
            PH_BEGIN(2) if (PHSEL < 0 || PHSEL == 2) even_ea(C, PROJ, LOGF, (float*)(ws + WS_KV), DEC); PH_END
            PH_BEGIN(4) if (PHSEL < 0 || PHSEL == 4) { if (dry_) even_eb<EBVAR>(C, PROJ, LOGF, (const float*)(ws + WS_KV), DEC, in[6] + j * DH, in[7] + j * DH, OBF); else even_eb<0>(C, PROJ, LOGF, (const float*)(ws + WS_KV), DEC, in[6] + j * DH, in[7] + j * DH, OBF); } PH_END
        } else {
            PH_BEGIN(5) if (PHSEL < 0 || PHSEL == 5) {
                pg8::Gemm g{XB, (const bf16*)(ws + WS_WIO) + (size_t)j * 8192 * DM, M, 8192, DM}; pg8::StaticOrder S; S.init(M, 8192, C.G, C.bx);
                pg8::Unit u0; S.next(0, u0); prep_rstd(C, RS, u0.pm, (LAS float*)(C.lds + CS_OFF + 8192));
                pg8::EpiOdd E{PROJ, PROJ + (size_t)3 * M * DM, pg8::RstdLds{(PG8_LAS float*)(C.lds + CS_OFF + 8192)}, (unsigned*)(ws + WS_CTL) + CW_NRM + (l >> 1) * 512, (PG8_LAS float*)(C.lds + CS_OFF)};
                if (NULLEPI == 1 && dry_) { pg8::EpiNull EN{(float*)(ws + WS_ST)}; pg8::gemm_phase<pg8::EpiNull, pg8::StaticOrder, true, true>(C.lds, g, S, EN); }
                else if (NULLEPI == 2 && dry_) { pg8::EpiProbe<1> EP{(bf16*)(ws + 940 * MiB), (bf16*)(ws + 940 * MiB) + (size_t)3 * M * DM, RS}; pg8::gemm_phase<pg8::EpiProbe<1>, pg8::StaticOrder, true, true>(C.lds, g, S, EP); }
                else if (NULLEPI == 3 && dry_) { pg8::EpiProbe<2> EP{(bf16*)(ws + 940 * MiB), (bf16*)(ws + 940 * MiB) + (size_t)3 * M * DM, RS}; pg8::gemm_phase<pg8::EpiProbe<2>, pg8::StaticOrder, true, true>(C.lds, g, S, EP); }
                else if (NULLEPI == 4 && dry_) { pg8::EpiProbe<3> EP{(bf16*)(ws + 940 * MiB), (bf16*)(ws + 940 * MiB) + (size_t)3 * M * DM, RS}; pg8::gemm_phase<pg8::EpiProbe<3>, pg8::StaticOrder, true, true>(C.lds, g, S, EP); }
                else pg8::gemm_phase<pg8::EpiOdd, pg8::StaticOrder, true, true>(C.lds, g, S, E);
                flogit_phase(C, XB, (const bf16*)(ws + WS_WF) + (size_t)j * 16 * DM, RS, in[10] + j * NFOX, LF); } PH_END
            PH_BEGIN(6) if (PHSEL < 0 || PHSEL == 6) { fox_phase(C, (char*)lds, PROJ, PROJ + (size_t)M * DM, PROJ + (size_t)2 * M * DM, PROJ + (size_t)3 * M * DM, OBF, LF, (const unsigned*)(ws + WS_CTL) + CW_NRM + (l >> 1) * 512, in[10] + j * NFOX);
                if (!dry_) conv_filler(l >> 1, in, ws, (unsigned*)(ws + WS_CTL) + CW_CONVQ + (l >> 1) * 64, C.lds); } PH_END
        }
        PH_BEGIN(7) if (PHSEL < 0 || PHSEL == 7) {
            const bf16* wo = (l & 1) ? (const bf16*)(ws + WS_WOO) + (size_t)j * DM * DM : (const bf16*)(ws + WS_WOE) + (size_t)j * DM * DM;
            pg8::Gemm g{OBF, wo, M, DM, DM}; pg8::StaticOrder S; S.init(M, DM, C.G, C.bx);
            pg8::EpiResid E{dry_ ? (bf16*)(ws + WS_ST) : XB, RS};
            if (NULLEPI == 1 && dry_) { pg8::EpiNull EN{(float*)(ws + WS_ST)}; pg8::gemm_phase<pg8::EpiNull, pg8::StaticOrder, true, true>(C.lds, g, S, EN); }
            else pg8::gemm_phase<pg8::EpiResid, pg8::StaticOrder, true, true>(C.lds, g, S, E); } PH_END
        PH_BEGIN(8) if (PHSEL < 0 || PHSEL == 8) {
            pg8::Gemm g{XB, (const bf16*)(ws + WS_WU) + (size_t)l * DFF2 * DM, M, DFF2, DM}; pg8::StaticOrder S; S.init(M, DFF2, C.G, C.bx);
            pg8::Unit u0; S.next(0, u0); prep_rstd(C, RS, u0.pm, (LAS float*)(C.lds + CS_OFF + 8192));
            pg8::EpiUpConv E{ACT, (float*)(ws + WS_SB), pg8::RstdLds{(PG8_LAS float*)(C.lds + CS_OFF + 8192)}, in[13] + (size_t)l * 3 * DFF2, (PG8_LAS float*)(C.lds + CS_OFF)};
            if (NULLEPI == 1 && dry_) { pg8::EpiNull EN{(float*)(ws + WS_ST)}; pg8::gemm_phase<pg8::EpiNull, pg8::StaticOrder, true, true>(C.lds, g, S, EN); }
            else pg8::gemm_phase<pg8::EpiUpConv, pg8::StaticOrder, true, true>(C.lds, g, S, E);
            if (!dry_ && l < 3) conv_filler(2 + l, in, ws, (unsigned*)(ws + WS_CTL) + CW_CONVQ + (2 + l) * 64, C.lds); } PH_END
        PH_BEGIN(9) if (PHSEL < 0 || PHSEL == 9) conv_fix(C, (const float*)(ws + WS_SB), in[13] + (size_t)l * 3 * DFF2, ACT); PH_END
        PH_BEGIN(10) if (PHSEL < 0 || PHSEL == 10) {
            pg8::Gemm g{ACT, (const bf16*)(ws + WS_WD) + (size_t)l * DM * DFF, M, DM, DFF}; pg8::StaticOrder S; S.init(M, DM, C.G, C.bx);
            pg8::EpiResid E{dry_ ? (bf16*)(ws + WS_ST) : XB, RS};
            if (NULLEPI == 1 && dry_) { pg8::EpiNull EN{(float*)(ws + WS_ST)}; pg8::gemm_phase<pg8::EpiNull, pg8::StaticOrder, true, true>(C.lds, g, S, EN); }
            else pg8::gemm_phase<pg8::EpiResid, pg8::StaticOrder, true, true>(C.lds, g, S, E); } PH_END
    }
    PH_BEGIN(11) if (PHSEL < 0 || PHSEL == 11) final_norm(C, XB, out, RS, in[3]); PH_END
#undef PH_BEGIN
#undef PH_END
}

extern "C" void kernel_launch(void* const* d_in, const int* in_sizes, int n_in, void* d_out, int out_size, void* d_ws, size_t ws_size, hipStream_t stream) {
    static int grid = 0;
    if (grid == 0) {
        if (n_in != 15 || in_sizes[0] != M * DM || out_size != M * DM || ws_size < WS_END) { fprintf(stderr, "kernel_launch: shape/workspace mismatch (n_in %d, in0 %d, out %d, ws %zu < %zu); nothing launched\n", n_in, n_in > 0 ? in_sizes[0] : -1, out_size, ws_size, (size_t)WS_END); grid = -1; return; }
        int dev = 0, cus = 0, per_cu = 0;
        if (hipGetDevice(&dev) != hipSuccess || hipDeviceGetAttribute(&cus, hipDeviceAttributeMultiprocessorCount, dev) != hipSuccess) { fprintf(stderr, "kernel_launch: device query failed\n"); grid = -1; return; }
        if (hipFuncSetAttribute((const void*)mk_fwd, hipFuncAttributeMaxDynamicSharedMemorySize, LDS_BYTES) != hipSuccess) { fprintf(stderr, "kernel_launch: hipFuncSetAttribute(%d B LDS) failed\n", LDS_BYTES); grid = -1; return; }
        if (hipOccupancyMaxActiveBlocksPerMultiprocessor(&per_cu, (const void*)mk_fwd, NWAVES * 64, LDS_BYTES) != hipSuccess || per_cu < 1) { fprintf(stderr, "kernel_launch: occupancy query reports %d workgroups per CU\n", per_cu); }
        (void)hipGetLastError();
        if (cus != 256) { fprintf(stderr, "kernel_launch: built for a 256-CU device (MI355X): the per-phase row-panel ownership of the GEMM phases assumes a 256-workgroup grid; this device has %d CUs; nothing launched\n", cus); grid = -1; return; }
        grid = cus;
    }
    if (grid < 0) return;
    if (hipMemsetAsync((char*)d_ws + WS_CTL, 0, CTL_ZERO_BYTES, stream) != hipSuccess) { fprintf(stderr, "kernel_launch: memset failed\n"); return; }
    Args a{};
    for (int i = 0; i < 15; ++i) a.in[i] = (const float*)d_in[i];
    a.out = (float*)d_out; a.ws = (unsigned char*)d_ws;
    if (MK_N_LAUNCHES == 1) { a.ph_lo = 0; a.ph_hi = N_PHASES; hipLaunchKernelGGL(mk_fwd, dim3(grid), dim3(NWAVES * 64), LDS_BYTES, stream, a); }
    else for (int p = 0; p < N_PHASES; ++p) { a.ph_lo = p; a.ph_hi = p + 1; hipLaunchKernelGGL(mk_fwd, dim3(grid), dim3(NWAVES * 64), LDS_BYTES, stream, a); }
    const hipError_t le = hipPeekAtLastError();
    if (le != hipSuccess) fprintf(stderr, "kernel_launch: launch failed: %s\n", hipGetErrorName(le));
}
```

```cpp
#include <hip/hip_runtime.h>
#include <cstdio>
#include <cstdint>
#define MK_N_LAUNCHES 1
namespace pg8 {
#define PG8_LAS __attribute__((address_space(3)))
typedef unsigned short bf16_t;
typedef short bf16x8 __attribute__((ext_vector_type(8)));
typedef float f32x4 __attribute__((ext_vector_type(4)));
typedef unsigned u32x4 __attribute__((ext_vector_type(4)));
constexpr int BM = 256, BK = 64, HALF = 128, HTB = HALF * BK * 2  , STAGE_BYTES = 8 * HTB, NXCD = 8, WGM = 8;

__host__ __device__ __forceinline__ int lds_byte(int r, int c) { const int st = (r >> 4) * 2 + (c >> 5), rr = r & 15, cc = c & 31, ob = rr * 64 + cc * 2; return st * 1024 + (ob ^ (((ob >> 9) & 1) << 5)); }
__host__ __device__ __forceinline__ void stage_rc(int b, int& R, int& C) { const int st = b / 1024, sb = b % 1024, swz = sb ^ (((sb >> 9) & 1) << 5); R = (st >> 1) * 16 + swz / 64; C = (st & 1) * 32 + (swz % 64) / 2; }
__host__ __device__ __forceinline__ int perm32(int rho) { const int n = rho >> 4, i = rho & 15; return 8 * (i >> 2) + 4 * n + (i & 3); }

struct Unit { int pm, pn; };
struct Gemm { const bf16_t* A; const bf16_t* Bt; int M, N, K; };

struct StaticOrder {
    int nM, nN, nwg, G, c;
    __host__ __device__ void init(int M, int N, int G_, int c_) { nM = M / BM; nN = N / BM; nwg = nM * nN; G = G_; c = c_; }
    __host__ __device__ __forceinline__ bool next(int i, Unit& u) const {
        const long L = (long)i * G + c; if (L >= nwg) return false;
        int wgid = (int)L; { const int q = nwg / NXCD, r = nwg % NXCD, xcd = wgid % NXCD, off = wgid / NXCD; wgid = (xcd < r ? xcd * (q + 1) : r * (q + 1) + (xcd - r) * q) + off; }
        const int nig = WGM * nN, gid = wgid / nig, fm = gid * WGM, gsz = (nM - fm) < WGM ? (nM - fm) : WGM;
        u.pm = fm + ((wgid % nig) % gsz); u.pn = (wgid % nig) / gsz; return true;
    }
    __device__ __forceinline__ void a_ready(const Unit&) const {}
    __device__ __forceinline__ void done(const Unit&) const {}
};
__device__ __forceinline__ int lane_now() { int l; asm volatile("v_mbcnt_lo_u32_b32 %0, -1, 0\n\tv_mbcnt_hi_u32_b32 %0, -1, %0" : "=v"(l)); return l; }
__device__ __forceinline__ float shfl_xor_l(float v, int m, int lane) { return __builtin_bit_cast(float, __builtin_amdgcn_ds_bpermute((lane ^ m) << 2, __builtin_bit_cast(int, v))); }
__device__ __forceinline__ float shfl_up_l(float v, int d, int lane) { return __builtin_bit_cast(float, __builtin_amdgcn_ds_bpermute((lane - d) << 2, __builtin_bit_cast(int, v))); }
__device__ __forceinline__ unsigned cvt_pk_bf16(float lo, float hi) { unsigned r; asm volatile("s_nop 0\n\tv_cvt_pk_bf16_f32 %0, %1, %2" : "=v"(r) : "v"(lo), "v"(hi)); return r; }
typedef float cvt_f32x2 __attribute__((ext_vector_type(2)));
typedef __bf16 cvt_bf16x2 __attribute__((ext_vector_type(2)));
__device__ __forceinline__ unsigned cvt_pk_bf16_c(float lo, float hi) { const cvt_bf16x2 v = __builtin_convertvector((cvt_f32x2){lo, hi}, cvt_bf16x2); return __builtin_bit_cast(unsigned, v); }
typedef unsigned u32x2 __attribute__((ext_vector_type(2)));
typedef float f32x2 __attribute__((ext_vector_type(2)));
typedef _Float16 h16x8 __attribute__((ext_vector_type(8)));
constexpr int EM = 16384, ED = 2048;
constexpr float RMS_EPS = 1e-6f;
__device__ __forceinline__ float fsigmoid(float x) { return __builtin_amdgcn_rcpf(1.f + __expf(-x)); }
__device__ __forceinline__ float row_rstd(const float* rsp, int row, int fq) { const f32x4 a = *(const f32x4*)(rsp + (size_t)row * 32 + fq * 8), b = *(const f32x4*)(rsp + (size_t)row * 32 + fq * 8 + 4);
    float s = ((a[0] + a[1]) + (a[2] + a[3])) + ((b[0] + b[1]) + (b[2] + b[3])); { const int l_ = lane_now(); s += shfl_xor_l(s, 16, l_); s += shfl_xor_l(s, 32, l_); } return __builtin_amdgcn_rsqf(s * (1.0f / (float)ED) + RMS_EPS); }
struct RstdLds { const PG8_LAS float* tab; };
__device__ __forceinline__ void rstd_get8(const RstdLds& R, int rloc0, float (&r)[2][4]) {
#pragma unroll
    for (int ai = 0; ai < 2; ++ai)
#pragma unroll
        for (int m = 0; m < 4; ++m) r[ai][m] = R.tab[rloc0 + ai * HALF + m * 16];
}
__device__ __forceinline__ u32x4 pack8f(const float (&v)[8]) { u32x4 w; w.x = cvt_pk_bf16(v[0], v[1]); w.y = cvt_pk_bf16(v[2], v[3]); w.z = cvt_pk_bf16(v[4], v[5]); w.w = cvt_pk_bf16(v[6], v[7]); return w; }

struct EpiResid {
    static constexpr bool PERM = true, AFTER_DRAIN = false, APERM = false;
    bf16_t* xb; float* rs;
    __device__ __forceinline__ void operator()(const f32x4 (&acc)[2][2][4][2], const Unit& u, int wr, int wc, int fr, int fq) const {
        const int row0 = u.pm * BM + wr * 64 + fr, col0 = u.pn * BM + wc * 32 + 8 * fq;
#pragma unroll
        for (int ai = 0; ai < 2; ++ai) {
            u32x4 xo[4][2];
#pragma unroll
            for (int m = 0; m < 4; ++m)
#pragma unroll
                for (int bj = 0; bj < 2; ++bj) xo[m][bj] = *(const u32x4*)(xb + (size_t)(row0 + ai * HALF + m * 16) * ED + col0 + bj * HALF);
#pragma unroll
            for (int m = 0; m < 4; ++m) { const int row = row0 + ai * HALF + m * 16; bf16_t* rowp = xb + (size_t)row * ED + col0; float ss = 0.f;
#pragma unroll
                for (int bj = 0; bj < 2; ++bj) { float v[8];
#pragma unroll
                    for (int e = 0; e < 4; ++e) { v[2 * e] = __uint_as_float(xo[m][bj][e] << 16) + acc[ai][bj][m][e >> 1][(2 * e) & 3]; v[2 * e + 1] = __uint_as_float(xo[m][bj][e] & 0xffff0000u) + acc[ai][bj][m][e >> 1][(2 * e + 1) & 3]; }
#pragma unroll
                    for (int e = 0; e < 8; ++e) ss += v[e] * v[e];
                    *(u32x4*)(rowp + bj * HALF) = pack8f(v); }
                { const int l_ = lane_now(); ss += shfl_xor_l(ss, 16, l_); ss += shfl_xor_l(ss, 32, l_); }
                if (fq == 0) rs[(size_t)row * 32 + u.pn * 4 + wc] = ss; }
            asm volatile("" ::: "memory"); }
    }
};
struct EpiUp {
    static constexpr bool PERM = true, AFTER_DRAIN = false, APERM = false;
    bf16_t* O; int ldc; const float* rs;
    __device__ __forceinline__ void operator()(const f32x4 (&acc)[2][2][4][2], const Unit& u, int wr, int wc, int fr, int fq) const {
        const int row0 = u.pm * BM + wr * 64 + fr, col0 = u.pn * BM + wc * 32 + 8 * fq;
#pragma unroll
        for (int ai = 0; ai < 2; ++ai)
#pragma unroll
            for (int m = 0; m < 4; ++m) { const int row = row0 + ai * HALF + m * 16; const float rstd = row_rstd(rs, row, fq); bf16_t* rowp = O + (size_t)row * ldc + col0;
#pragma unroll
                for (int bj = 0; bj < 2; ++bj) { const f32x4 v0 = acc[ai][bj][m][0] * rstd, v1 = acc[ai][bj][m][1] * rstd;
                    u32x4 w; w.x = cvt_pk_bf16(v0[0], v0[1]); w.y = cvt_pk_bf16(v0[2], v0[3]); w.z = cvt_pk_bf16(v1[0], v1[1]); w.w = cvt_pk_bf16(v1[2], v1[3]);
                    *(u32x4*)(rowp + bj * HALF) = w; } }
    }
};
__device__ __forceinline__ float dpp_shr1_old(float x, float old) { return __builtin_bit_cast(float, __builtin_amdgcn_update_dpp(__builtin_bit_cast(int, old), __builtin_bit_cast(int, x), 0x111, 0xf, 0xf, false)); }
__device__ __forceinline__ float dpp_ror1(float y) { return __builtin_bit_cast(float, __builtin_amdgcn_mov_dpp(__builtin_bit_cast(int, y), 0x121, 0xf, 0xf, false)); }
__device__ __forceinline__ float dpp_ror2(float y) { return __builtin_bit_cast(float, __builtin_amdgcn_mov_dpp(__builtin_bit_cast(int, y), 0x122, 0xf, 0xf, false)); }
struct EpiUpConv {
    static constexpr bool PERM = true, AFTER_DRAIN = false, APERM = true;
    bf16_t* act; float* sb; RstdLds rl; const float* cw; PG8_LAS float* halo;
    __device__ __forceinline__ void operator()(const f32x4 (&acc)[2][2][4][2], const Unit& u, int wr, int wc, int fr, int fq) const {
        const int row0 = u.pm * BM + wr * 64 + 4 * fr, cl = wc * 32 + 8 * fq, ccol = u.pn * 128 + cl;
        float rstd[2][4];
        { const f32x4 t0 = *(const PG8_LAS f32x4*)(rl.tab + wr * 64 + 4 * fr), t1 = *(const PG8_LAS f32x4*)(rl.tab + HALF + wr * 64 + 4 * fr);
#pragma unroll
          for (int m = 0; m < 4; ++m) { rstd[0][m] = t0[m]; rstd[1][m] = t1[m]; } }
        if (fr == 15) {
#pragma unroll
            for (int ai = 0; ai < 2; ++ai)
#pragma unroll
                for (int r = 0; r < 2; ++r) { PG8_LAS float* hp = halo + ((2 * ai + wr) * 2 + r) * 256 + cl;
#pragma unroll
                    for (int bj = 0; bj < 2; ++bj) { *(PG8_LAS f32x4*)(hp + bj * 128) = acc[ai][bj][2 + r][0] * rstd[ai][2 + r]; *(PG8_LAS f32x4*)(hp + bj * 128 + 4) = acc[ai][bj][2 + r][1] * rstd[ai][2 + r]; } }
            if (wr == 1) {
#pragma unroll
                for (int r = 0; r < 2; ++r) { float* sp = sb + ((size_t)(u.pm * 4 + 2 + r)) * 11008 + u.pn * 256 + cl;
#pragma unroll
                    for (int bj = 0; bj < 2; ++bj) { *(f32x4*)(sp + bj * 128) = acc[1][bj][2 + r][0] * rstd[1][2 + r]; *(f32x4*)(sp + bj * 128 + 4) = acc[1][bj][2 + r][1] * rstd[1][2 + r]; } } }
        }
        if (fr == 0 && wr == 0) {
#pragma unroll
            for (int r = 0; r < 2; ++r) { float* sp = sb + ((size_t)(u.pm * 4 + r)) * 11008 + u.pn * 256 + cl;
#pragma unroll
                for (int bj = 0; bj < 2; ++bj) { *(f32x4*)(sp + bj * 128) = acc[0][bj][r][0] * rstd[0][r]; *(f32x4*)(sp + bj * 128 + 4) = acc[0][bj][r][1] * rstd[0][r]; } } }
        asm volatile("s_waitcnt lgkmcnt(0)" ::: "memory"); __builtin_amdgcn_s_barrier(); asm volatile("" ::: "memory");
        u32x2 pk0[2][4];
#pragma unroll
        for (int hf = 0; hf < 2; ++hf) {
            f32x2 wg[3][2], wv[3][2];
#pragma unroll
            for (int j = 0; j < 3; ++j) { const f32x4 a = *(const f32x4*)(cw + j * 11008 + ccol + 4 * hf), c = *(const f32x4*)(cw + j * 11008 + 5504 + ccol + 4 * hf);
                wg[j][0] = (f32x2){a[0], a[1]}; wg[j][1] = (f32x2){a[2], a[3]}; wv[j][0] = (f32x2){c[0], c[1]}; wv[j][1] = (f32x2){c[2], c[3]}; }
#pragma unroll
            for (int ai = 0; ai < 2; ++ai) {
                const int sprev = 2 * ai + wr - 1;
                f32x4 h0g = {0.f, 0.f, 0.f, 0.f}, h0v = h0g, h1g = h0g, h1v = h0g;
                if (sprev >= 0) { const PG8_LAS float* hp = halo + (sprev * 2) * 256 + cl + 4 * hf;
                    h0g = *(const PG8_LAS f32x4*)hp; h0v = *(const PG8_LAS f32x4*)(hp + 128); h1g = *(const PG8_LAS f32x4*)(hp + 256); h1v = *(const PG8_LAS f32x4*)(hp + 256 + 128); }
                float o[4][4];
#pragma unroll
                for (int q = 0; q < 2; ++q) { f32x2 xg[4], xv[4];
#pragma unroll
                    for (int m = 0; m < 4; ++m) { const f32x2 r2 = {rstd[ai][m], rstd[ai][m]};
                        xg[m] = (f32x2){acc[ai][0][m][hf][2 * q], acc[ai][0][m][hf][2 * q + 1]} * r2; xv[m] = (f32x2){acc[ai][1][m][hf][2 * q], acc[ai][1][m][hf][2 * q + 1]} * r2; }
                    const f32x2 s3g = {dpp_shr1_old(xg[3].x, h1g[2 * q]), dpp_shr1_old(xg[3].y, h1g[2 * q + 1])}, s2g = {dpp_shr1_old(xg[2].x, h0g[2 * q]), dpp_shr1_old(xg[2].y, h0g[2 * q + 1])};
                    const f32x2 s3v = {dpp_shr1_old(xv[3].x, h1v[2 * q]), dpp_shr1_old(xv[3].y, h1v[2 * q + 1])}, s2v = {dpp_shr1_old(xv[2].x, h0v[2 * q]), dpp_shr1_old(xv[2].y, h0v[2 * q + 1])};
                    f32x2 cg[4], cv[4];
                    cg[0] = wg[0][q] * s2g + (wg[1][q] * s3g + wg[2][q] * xg[0]);     cv[0] = wv[0][q] * s2v + (wv[1][q] * s3v + wv[2][q] * xv[0]);
                    cg[1] = wg[0][q] * s3g + (wg[1][q] * xg[0] + wg[2][q] * xg[1]);   cv[1] = wv[0][q] * s3v + (wv[1][q] * xv[0] + wv[2][q] * xv[1]);
                    cg[2] = wg[0][q] * xg[0] + (wg[1][q] * xg[1] + wg[2][q] * xg[2]); cv[2] = wv[0][q] * xv[0] + (wv[1][q] * xv[1] + wv[2][q] * xv[2]);
                    cg[3] = wg[0][q] * xg[1] + (wg[1][q] * xg[2] + wg[2][q] * xg[3]); cv[3] = wv[0][q] * xv[1] + (wv[1][q] * xv[2] + wv[2][q] * xv[3]);
#pragma unroll
                    for (int m = 0; m < 4; ++m) {
                        const f32x2 t = cg[m] * (f32x2){-1.4426950408889634f, -1.4426950408889634f};
                        const f32x2 d = (f32x2){__builtin_amdgcn_exp2f(t.x), __builtin_amdgcn_exp2f(t.y)} + (f32x2){1.f, 1.f};
                        const f32x2 y = (cg[m] * cv[m]) * (f32x2){__builtin_amdgcn_rcpf(d.x), __builtin_amdgcn_rcpf(d.y)}; o[m][2 * q] = y.x; o[m][2 * q + 1] = y.y; } }
#pragma unroll
                for (int m = 0; m < 4; ++m) { u32x2 w2; w2.x = cvt_pk_bf16(o[m][0], o[m][1]); w2.y = cvt_pk_bf16(o[m][2], o[m][3]);
                    if (hf == 0) pk0[ai][m] = w2;
                    else { u32x4 w4; w4.x = pk0[ai][m].x; w4.y = pk0[ai][m].y; w4.z = w2.x; w4.w = w2.y; *(u32x4*)(act + (size_t)(row0 + ai * HALF + m) * 5504 + ccol) = w4; } }
            }
        }
    }
};
struct EpiEven {
    static constexpr bool PERM = true, AFTER_DRAIN = false, APERM = false;
    bf16_t* proj; _Float16* logf; RstdLds rl; const float* lbl;
    int jl;
    __device__ __forceinline__ void operator()(const f32x4 (&acc)[2][2][4][2], const Unit& u, int wr, int wc, int fr, int fq) const {
        const int seg = u.pn >> 2, cs0 = (u.pn & 3) * 256 + wc * 32 + 8 * fq, row0 = u.pm * BM + wr * 64 + fr;
        const size_t ho0 = (size_t)((u.pn & 3) * 2) * EM * 128 + wc * 32 + 8 * fq;
        bf16_t* segp = proj + (size_t)seg * EM * 1024;
        float rstd8[2][4];
        rstd_get8(rl, wr * 64 + fr, rstd8);
        if (seg == 1) {
            float lb[2][8];
#pragma unroll
            for (int bj = 0; bj < 2; ++bj)
#pragma unroll
                for (int e = 0; e < 8; ++e) { const int c = cs0 + bj * HALF + e; lb[bj][e] = jl ? fsigmoid(lbl[1024 + c] - lbl[c]) : 0.f; }
            if (jl) {
#pragma unroll
            for (int ai = 0; ai < 2; ++ai)
#pragma unroll
                for (int m = 0; m < 4; ++m) { const int row = row0 + ai * HALF + m * 16; const float nrl = rstd8[ai][m] * -1.4426950408889634f;
#pragma unroll
                    for (int bj = 0; bj < 2; ++bj) { h16x8 lh;
#pragma unroll
                        for (int e = 0; e < 8; ++e) { const float ez = __builtin_amdgcn_exp2f(__builtin_amdgcn_fmed3f(acc[ai][bj][m][e >> 2][e & 3] * nrl, -115.4f, 115.4f));
                            const float l2 = __builtin_amdgcn_logf(__builtin_fmaf(lb[bj][e], ez, 1.f)) - __builtin_amdgcn_logf(1.f + ez);
                            lh[e] = (_Float16)(l2 * 0.6931471805599453f); }
                        const size_t o = ho0 + ((size_t)bj * EM + row) * 128;
                        *(h16x8*)(logf + o) = lh; } }
            } else {
#pragma unroll
            for (int ai = 0; ai < 2; ++ai)
#pragma unroll
                for (int m = 0; m < 4; ++m) { const int row = row0 + ai * HALF + m * 16; const float nrl = rstd8[ai][m] * -1.4426950408889634f;
#pragma unroll
                    for (int bj = 0; bj < 2; ++bj) { h16x8 lh;
#pragma unroll
                        for (int e = 0; e < 8; ++e) { const float ez = __builtin_amdgcn_exp2f(__builtin_amdgcn_fmed3f(acc[ai][bj][m][e >> 2][e & 3] * nrl, -115.4f, 115.4f));
                            const float l2 = -__builtin_amdgcn_logf(1.f + ez);
                            lh[e] = (_Float16)(l2 * 0.6931471805599453f); }
                        const size_t o = ho0 + ((size_t)bj * EM + row) * 128;
                        *(h16x8*)(logf + o) = lh; } }
            }
        } else if (seg == 4 || seg == 5) {
            const float sc = seg == 5 ? 0.08838834764831845f : 1.f;
            float invf[4];
#pragma unroll
            for (int i = 0; i < 4; ++i) invf[i] = exp2f(-(float)(wc * 16 + 4 * fq + i) * (13.287712379549449f / 64.f));
#pragma unroll
            for (int ai = 0; ai < 2; ++ai)
#pragma unroll
                for (int m = 0; m < 4; ++m) { const int row = row0 + ai * HALF + m * 16; const float rstd = rstd8[ai][m] * sc, tpos = (float)(row & 4095);
                    float cs[4], sn[4];
#pragma unroll
                    for (int i = 0; i < 4; ++i) { float rev = (tpos * invf[i]) * 0.15915494309189535f; rev = rev - floorf(rev); cs[i] = __builtin_amdgcn_cosf(rev); sn[i] = __builtin_amdgcn_sinf(rev); }
#pragma unroll
                    for (int bj = 0; bj < 2; ++bj) { float v[8];
#pragma unroll
                        for (int i = 0; i < 4; ++i) { const float x1 = acc[ai][bj][m][i >> 1][(2 * i) & 3] * rstd, x2 = acc[ai][bj][m][i >> 1][(2 * i + 1) & 3] * rstd;
                            v[2 * i] = x1 * cs[i] - x2 * sn[i]; v[2 * i + 1] = x2 * cs[i] + x1 * sn[i]; }
                        *(u32x4*)(segp + ho0 + ((size_t)bj * EM + row) * 128) = pack8f(v); } }
        } else {
            const bool act = (seg == 0 || seg == 3 || seg == 7);
            if (act) {
#pragma unroll
                for (int ai = 0; ai < 2; ++ai)
#pragma unroll
                    for (int m = 0; m < 4; ++m) { const int row = row0 + ai * HALF + m * 16; const float rstd = rstd8[ai][m], nrl = rstd * -1.4426950408889634f;
#pragma unroll
                        for (int bj = 0; bj < 2; ++bj) { float v[8];
#pragma unroll
                            for (int e = 0; e < 8; e += 2) { const f32x2 a = {acc[ai][bj][m][e >> 2][e & 3], acc[ai][bj][m][e >> 2][(e & 3) + 1]};
                                const f32x2 t = a * (f32x2){nrl, nrl}; const f32x2 d = (f32x2){__builtin_amdgcn_exp2f(t.x), __builtin_amdgcn_exp2f(t.y)} + (f32x2){1.f, 1.f};
                                const f32x2 y = (a * (f32x2){rstd, rstd}) * (f32x2){__builtin_amdgcn_rcpf(d.x), __builtin_amdgcn_rcpf(d.y)}; v[e] = y.x; v[e + 1] = y.y; }
                            *(u32x4*)(segp + ho0 + ((size_t)bj * EM + row) * 128) = pack8f(v); } }
            } else {
#pragma unroll
                for (int ai = 0; ai < 2; ++ai)
#pragma unroll
                    for (int m = 0; m < 4; ++m) { const int row = row0 + ai * HALF + m * 16; const float rstd = rstd8[ai][m];
#pragma unroll
                        for (int bj = 0; bj < 2; ++bj) { float v[8];
#pragma unroll
                            for (int e = 0; e < 8; ++e) v[e] = acc[ai][bj][m][e >> 2][e & 3] * rstd;
                            *(u32x4*)(segp + ho0 + ((size_t)bj * EM + row) * 128) = pack8f(v); } }
            }
        }
    }
};
struct EpiOdd {
    static constexpr bool PERM = true, AFTER_DRAIN = false, APERM = false;
    bf16_t* qkv; bf16_t* g; RstdLds rl;
    unsigned* nrm;
    PG8_LAS float* ex;
    __device__ __forceinline__ void operator()(const f32x4 (&acc)[2][2][4][2], const Unit& u, int wr, int wc, int fr, int fq) const {
        const int seg = u.pn >> 3, hh0 = (u.pn & 7) * 2, p0 = wc * 32 + 8 * fq, row0 = u.pm * BM + wr * 64 + fr;
        float rstd8[2][4];
        rstd_get8(rl, wr * 64 + fr, rstd8);
        if (seg == 3) {
#pragma unroll
            for (int ai = 0; ai < 2; ++ai)
#pragma unroll
                for (int m = 0; m < 4; ++m) { const int row = row0 + ai * HALF + m * 16; const float nrl = rstd8[ai][m] * -1.4426950408889634f;
#pragma unroll
                    for (int bj = 0; bj < 2; ++bj) { float v[8];
#pragma unroll
                        for (int e = 0; e < 8; e += 2) { const f32x2 t = (f32x2){acc[ai][bj][m][e >> 2][e & 3], acc[ai][bj][m][e >> 2][(e & 3) + 1]} * (f32x2){nrl, nrl};
                            const f32x2 d = (f32x2){__builtin_amdgcn_exp2f(t.x), __builtin_amdgcn_exp2f(t.y)} + (f32x2){1.f, 1.f}; v[e] = __builtin_amdgcn_rcpf(d.x); v[e + 1] = __builtin_amdgcn_rcpf(d.y); }
                        *(u32x4*)(g + (size_t)row * ED + (hh0 + bj) * 128 + p0) = pack8f(v); } }
        } else if (seg == 2) {
#pragma unroll
            for (int ai = 0; ai < 2; ++ai)
#pragma unroll
                for (int m = 0; m < 4; ++m) { const int row = row0 + ai * HALF + m * 16; const float rstd = rstd8[ai][m]; const int b = row >> 12, t = row & 4095;
#pragma unroll
                    for (int bj = 0; bj < 2; ++bj) { float v[8];
#pragma unroll
                        for (int e = 0; e < 8; ++e) v[e] = acc[ai][bj][m][e >> 2][e & 3] * rstd;
                        *(u32x4*)(qkv + (size_t)2 * EM * ED + ((size_t)(b * 16 + hh0 + bj) * 4096 + t) * 128 + p0) = pack8f(v); } }
        } else {
#pragma unroll
            for (int ai = 0; ai < 2; ++ai)
#pragma unroll
                for (int m = 0; m < 4; ++m) { const int row = row0 + ai * HALF + m * 16; const float rstd = rstd8[ai][m]; const int b = row >> 12, t = row & 4095;
#pragma unroll
                    for (int bj = 0; bj < 2; ++bj) { float v[8];
#pragma unroll
                        for (int e = 0; e < 8; ++e) v[e] = acc[ai][bj][m][e >> 2][e & 3] * rstd;
                        *(u32x4*)(qkv + (size_t)seg * EM * ED + ((size_t)(b * 16 + hh0 + bj) * 4096 + t) * 128 + p0) = pack8f(v);
                        float s = 0.f;
#pragma unroll
                        for (int e = 0; e < 8; ++e) s += v[e] * v[e];
                        { const int l_ = lane_now(); s += shfl_xor_l(s, 16, l_); s += shfl_xor_l(s, 32, l_); }
                        if (fq == 0) ex[(wc * 2 + bj) * 256 + ai * HALF + wr * 64 + m * 16 + fr] = s; } }
        }
        if (seg < 2) {
            asm volatile("s_waitcnt lgkmcnt(0)" ::: "memory"); __builtin_amdgcn_s_barrier(); asm volatile("" ::: "memory");
            const int bj = wr, rl_ = wc * 64 + fq * 16 + fr;
            float s = (ex[(0 * 2 + bj) * 256 + rl_] + ex[(1 * 2 + bj) * 256 + rl_]) + (ex[(2 * 2 + bj) * 256 + rl_] + ex[(3 * 2 + bj) * 256 + rl_]);
            { const int l_ = lane_now();
#pragma unroll
              for (int o = 1; o < 64; o <<= 1) s = fmaxf(s, shfl_xor_l(s, o, l_)); }
            if (fr == 0 && fq == 0) atomicMax(nrm + (seg * 64 + (u.pm >> 4) * 16 + hh0 + bj) * 4, __float_as_uint(s)); }
    }
};

struct EpiNull {
    static constexpr bool PERM = false, AFTER_DRAIN = false, APERM = false;
    float* sink;
    __device__ __forceinline__ void operator()(const f32x4 (&acc)[2][2][4][2], const Unit& u, int wr, int wc, int fr, int fq) const {
        float s = 0.f;
#pragma unroll
        for (int ai = 0; ai < 2; ++ai)
#pragma unroll
            for (int bj = 0; bj < 2; ++bj)
#pragma unroll
                for (int m = 0; m < 4; ++m)
#pragma unroll
                    for (int n = 0; n < 2; ++n) s += (acc[ai][bj][m][n][0] + acc[ai][bj][m][n][1]) + (acc[ai][bj][m][n][2] + acc[ai][bj][m][n][3]);
        if (s == 123456.789f) sink[0] = s;
    }
};

template <int MODE> struct EpiProbe {
    static constexpr bool PERM = true, AFTER_DRAIN = false, APERM = false;
    bf16_t* qkv; bf16_t* g; const float* rs;
    __device__ __forceinline__ void operator()(const f32x4 (&acc)[2][2][4][2], const Unit& u, int wr, int wc, int fr, int fq) const {
        const int seg = u.pn >> 3, hh0 = (u.pn & 7) * 2, p0 = wc * 32 + 8 * fq, row0 = u.pm * BM + wr * 64 + fr;
        float sink = 0.f;
#pragma unroll
        for (int ai = 0; ai < 2; ++ai)
#pragma unroll
            for (int m = 0; m < 4; ++m) { const int row = row0 + ai * HALF + m * 16; const float rstd = MODE == 2 ? row_rstd(rs, row, fq) : (MODE == 3 ? 1.0001f : 1.f); const int b = row >> 12, t = row & 4095;
#pragma unroll
                for (int bj = 0; bj < 2; ++bj) { float v[8]; const int hh = hh0 + bj;
#pragma unroll
                    for (int e = 0; e < 8; ++e) { const float x = acc[ai][bj][m][e >> 2][e & 3] * rstd; v[e] = (MODE >= 2 && seg == 3) ? fsigmoid(x) : x; }
                    bf16_t* dst = (seg == 3) ? g + (size_t)row * ED + hh * 128 + p0 : qkv + (size_t)seg * EM * ED + ((size_t)(b * 16 + hh) * 4096 + t) * 128 + p0;
                    const u32x4 w = pack8f(v);
                    if (MODE == 1) *(u32x4*)dst = w; else sink += __uint_as_float(w.x ^ w.y ^ w.z ^ w.w); } }
        if (MODE >= 2 && sink == 123456.789f) qkv[0] = 1;
    }
};
template <class Epi, class Sched, bool ALIGN_EPI = false, bool SP2 = false>
__device__ __forceinline__ void gemm_phase(PG8_LAS unsigned char* lds, const Gemm g, const Sched& S, const Epi& E) {
    int tid_ = threadIdx.x; asm volatile("" : "+v"(tid_));
    const int tid = tid_, wid = __builtin_amdgcn_readfirstlane(tid >> 6), lane = tid & 63, wr = wid >> 2, wc = wid & 3, fr = lane & 15, fq = lane >> 4;
    const int K = g.K, nt = K / BK;
    unsigned voffA[2], voffB[2];
#pragma unroll
    for (int i = 0; i < 2; ++i) { int R, C; stage_rc(tid * 16 + i * 8192, R, C); const int Rb = Epi::PERM ? ((R & ~31) + perm32(R & 31)) : R;
        const int Ra = Epi::APERM ? ((R & 64) | (4 * (R & 15)) | ((R >> 4) & 3)) : R;
        voffA[i] = (unsigned)(Ra * K + C) * 2u; voffB[i] = (unsigned)(Rb * K + C) * 2u; }
    const size_t kstep = (size_t)(BK * 2);
    const size_t hstep = (size_t)HALF * K * 2;
    const size_t tstep = 2 * hstep;
    const unsigned ldsw = (unsigned)wid * 1024u;
    const int aoff = lds_byte(wr * 64 + fr, fq * 8), boff = lds_byte(wc * 32 + fr, fq * 8);
#define PG8_SA(b, h) (((b) * 2 + (h)) * HTB)
#define PG8_SB(b, h) ((4 + (b) * 2 + (h)) * HTB)
#define PG8_STAGE(bufoff, gbase, voff) do { _Pragma("unroll") for (int _i = 0; _i < 2; ++_i) \
        __builtin_amdgcn_global_load_lds((const unsigned*)((const char*)(gbase) + (voff)[_i]), (PG8_LAS unsigned*)(lds + (bufoff) + ldsw + _i * 8192), 16, 0, 0); } while (0)
#define PG8_LDA(dst, b, h) do { _Pragma("unroll") for (int m = 0; m < 4; ++m) _Pragma("unroll") for (int k = 0; k < 2; ++k) dst[m][k] = *(const PG8_LAS bf16x8*)(lds + PG8_SA(b, h) + aoff + m * 2048 + k * 1024); } while (0)
#define PG8_LDB(dst, b, h) do { _Pragma("unroll") for (int n = 0; n < 2; ++n) _Pragma("unroll") for (int k = 0; k < 2; ++k) dst[n][k] = *(const PG8_LAS bf16x8*)(lds + PG8_SB(b, h) + boff + n * 2048 + k * 1024); } while (0)
#define PG8_MMA(ai, bj, At, Bt) do { __builtin_amdgcn_s_setprio(1); _Pragma("unroll") for (int m = 0; m < 4; ++m) _Pragma("unroll") for (int n = 0; n < 2; ++n) _Pragma("unroll") for (int k = 0; k < 2; ++k) \
        acc[ai][bj][m][n] = __builtin_amdgcn_mfma_f32_16x16x32_bf16(Bt[n][k], At[m][k], acc[ai][bj][m][n], 0, 0, 0); __builtin_amdgcn_s_setprio(0); } while (0)
#define PG8_WAIT_V(n) asm volatile("s_waitcnt vmcnt(" #n ")" ::: "memory")
#define PG8_WAIT_L(n) asm volatile("s_waitcnt lgkmcnt(" #n ")" ::: "memory")
#define PG8_BAR __builtin_amdgcn_s_barrier()
#define PG8_SCHED __builtin_amdgcn_sched_barrier(0)
    Unit cur, nxt; int ui = 0;
    if (!S.next(0, cur)) return;
    f32x4 acc[2][2][4][2];
#pragma unroll
    for (int a = 0; a < 2; ++a)
#pragma unroll
        for (int b = 0; b < 2; ++b)
#pragma unroll
            for (int m = 0; m < 4; ++m)
#pragma unroll
                for (int n = 0; n < 2; ++n) acc[a][b][m][n] = (f32x4){0.f, 0.f, 0.f, 0.f};
    bf16x8 At[4][2], B0[2][2], B1[2][2];
    const char* cA = (const char*)g.A + (size_t)cur.pm * tstep; const char* cB = (const char*)g.Bt + (size_t)cur.pn * tstep;
    S.a_ready(cur);
    if constexpr (SP2) {
        PG8_STAGE(PG8_SB(0, 0), cB, voffB); PG8_STAGE(PG8_SB(0, 1), cB + hstep, voffB); PG8_STAGE(PG8_SA(0, 0), cA, voffA); PG8_STAGE(PG8_SA(0, 1), cA + hstep, voffA);
        if (wr == 1) PG8_BAR;
        PG8_WAIT_V(2); PG8_BAR;
        PG8_STAGE(PG8_SB(1, 0), cB + kstep, voffB); PG8_STAGE(PG8_SA(1, 0), cA + kstep, voffA); PG8_STAGE(PG8_SB(1, 1), cB + hstep + kstep, voffB);
        PG8_WAIT_V(6); PG8_BAR;
    } else {
        PG8_STAGE(PG8_SB(0, 0), cB, voffB); PG8_STAGE(PG8_SA(0, 0), cA, voffA); PG8_STAGE(PG8_SB(0, 1), cB + hstep, voffB); PG8_STAGE(PG8_SA(0, 1), cA + hstep, voffA);
        if (wr == 1) PG8_BAR;
        PG8_WAIT_V(4); PG8_BAR;
        PG8_STAGE(PG8_SB(1, 0), cB + kstep, voffB); PG8_STAGE(PG8_SA(1, 0), cA + kstep, voffA); PG8_STAGE(PG8_SB(1, 1), cB + hstep + kstep, voffB);
        PG8_WAIT_V(6); PG8_BAR;
    }
    for (;;) {
        const bool has_next = S.next(ui + 1, nxt);
        const char* nA = has_next ? (const char*)g.A + (size_t)nxt.pm * tstep : cA; const char* nB = has_next ? (const char*)g.Bt + (size_t)nxt.pn * tstep : cB;
        for (int t = 0; t < nt; t += 2) {
            const bool last = (t == nt - 2);
            const char* a1 = cA + (size_t)(t + 1) * kstep;
            const char* a2 = last ? nA : cA + (size_t)(t + 2) * kstep; const char* b2 = last ? nB : cB + (size_t)(t + 2) * kstep;
            const char* a3 = a2 + kstep; const char* b3 = b2 + kstep;
            if (last && has_next) S.a_ready(nxt);
            if constexpr (SP2) {
            PG8_LDB(B0, 0, 0); PG8_LDB(B1, 0, 1); PG8_SCHED; PG8_LDA(At, 0, 0); PG8_STAGE(PG8_SA(1, 1), a1 + hstep, voffA);
            PG8_WAIT_V(8); PG8_WAIT_L(0); PG8_BAR; PG8_MMA(0, 0, At, B0); PG8_MMA(0, 1, At, B1); PG8_BAR; PG8_SCHED;
            PG8_LDA(At, 0, 1); PG8_STAGE(PG8_SB(0, 0), b2, voffB); PG8_STAGE(PG8_SB(0, 1), b2 + hstep, voffB); PG8_STAGE(PG8_SA(0, 0), a2, voffA);
            PG8_WAIT_V(8); PG8_WAIT_L(0); PG8_BAR; PG8_MMA(1, 0, At, B0); PG8_MMA(1, 1, At, B1); PG8_BAR; PG8_SCHED;
            PG8_LDB(B0, 1, 0); PG8_LDB(B1, 1, 1); PG8_SCHED; PG8_LDA(At, 1, 0); PG8_STAGE(PG8_SA(0, 1), a2 + hstep, voffA);
            PG8_WAIT_V(8); PG8_WAIT_L(0); PG8_BAR; PG8_MMA(0, 0, At, B0); PG8_MMA(0, 1, At, B1); PG8_BAR; PG8_SCHED;
            PG8_LDA(At, 1, 1); PG8_STAGE(PG8_SB(1, 0), b3, voffB); PG8_STAGE(PG8_SB(1, 1), b3 + hstep, voffB); PG8_STAGE(PG8_SA(1, 0), a3, voffA);
            PG8_WAIT_V(8); PG8_WAIT_L(0); PG8_BAR; PG8_MMA(1, 0, At, B0); PG8_MMA(1, 1, At, B1); PG8_BAR; PG8_SCHED;
            } else {
            PG8_LDB(B0, 0, 0); PG8_SCHED; PG8_LDA(At, 0, 0); PG8_STAGE(PG8_SA(1, 1), a1 + hstep, voffA);
            PG8_WAIT_L(8); PG8_BAR; PG8_WAIT_L(0); PG8_MMA(0, 0, At, B0); PG8_BAR; PG8_SCHED;
            PG8_LDB(B1, 0, 1); PG8_STAGE(PG8_SB(0, 0), b2, voffB);
            PG8_BAR; PG8_WAIT_L(0); PG8_MMA(0, 1, At, B1); PG8_BAR;
            PG8_LDA(At, 0, 1); PG8_STAGE(PG8_SA(0, 0), a2, voffA);
            PG8_BAR; PG8_WAIT_L(0); PG8_MMA(1, 0, At, B0); PG8_BAR; PG8_SCHED;
            PG8_STAGE(PG8_SB(0, 1), b2 + hstep, voffB);
            PG8_WAIT_V(6); PG8_BAR; PG8_MMA(1, 1, At, B1); PG8_BAR;
            PG8_LDB(B0, 1, 0); PG8_SCHED; PG8_LDA(At, 1, 0); PG8_STAGE(PG8_SA(0, 1), a2 + hstep, voffA);
            PG8_WAIT_L(8); PG8_BAR; PG8_WAIT_L(0); PG8_MMA(0, 0, At, B0); PG8_BAR; PG8_SCHED;
            PG8_LDB(B1, 1, 1); PG8_STAGE(PG8_SB(1, 0), b3, voffB);
            PG8_BAR; PG8_WAIT_L(0); PG8_MMA(0, 1, At, B1); PG8_BAR;
            PG8_LDA(At, 1, 1); PG8_STAGE(PG8_SA(1, 0), a3, voffA);
            PG8_BAR; PG8_WAIT_L(0); PG8_MMA(1, 0, At, B0); PG8_BAR; PG8_SCHED;
            PG8_STAGE(PG8_SB(1, 1), b3 + hstep, voffB);
            PG8_WAIT_V(6); PG8_BAR; PG8_MMA(1, 1, At, B1); PG8_BAR;
            }
        }
        if constexpr (ALIGN_EPI) { if (wr == 0) PG8_BAR; }
        if constexpr (!Epi::AFTER_DRAIN) { E(acc, cur, wr, wc, fr, fq); S.done(cur); }
        if (!has_next) break;
#pragma unroll
        for (int a = 0; a < 2; ++a)
#pragma unroll
            for (int b = 0; b < 2; ++b)
#pragma unroll
                for (int m = 0; m < 4; ++m)
#pragma unroll
                    for (int n = 0; n < 2; ++n) acc[a][b][m][n] = (f32x4){0.f, 0.f, 0.f, 0.f};
        cur = nxt; cA = nA; cB = nB; ++ui;
        if constexpr (ALIGN_EPI) { if (wr == 1) PG8_BAR; }
    }
    PG8_WAIT_V(0);
    if constexpr (!ALIGN_EPI) { if (wr == 0) PG8_BAR; }
    PG8_BAR;
    if constexpr (Epi::AFTER_DRAIN) { E.fused(acc, cur, wr, wc, fr, fq, lds, wid, lane); S.done(cur); }
#undef PG8_SA
#undef PG8_SB
#undef PG8_STAGE
#undef PG8_LDA
#undef PG8_LDB
#undef PG8_MMA
#undef PG8_WAIT_V
#undef PG8_WAIT_L
#undef PG8_BAR
#undef PG8_SCHED
}
}
#include <hip/hip_bf16.h>
namespace fox {
enum { ORDER_NATURAL = 0, ORDER_REVERSED = 1, ORDER_PAIRED = 2, ORDER_XCD = 4 };
constexpr int B = 4, H = 16, HKV = 16, SQ = 4096, SKV = 4096, D = 128, QOFF = 0, WINDOW = SKV, OP = 2048;
constexpr float THR = 8.f;
constexpr int ORDER = ORDER_PAIRED;
constexpr bool WSKIP = false;
constexpr float SCALE = 0.08838834764831845f;
constexpr int NW = 8, QBLK = 32, KVBLK = 64, QB = NW * QBLK;
constexpr int SHM_V = KVBLK * D * 2, SHM_K = KVBLK * D * 2;
constexpr int LDS_BYTES = 2 * SHM_V + 2 * SHM_K + NW * 64 * 4;
constexpr int OST_OFF = LDS_BYTES, OST_BYTES = NW * 8192;
static_assert(D == 128 && SQ % QB == 0 && SKV % KVBLK == 0 && H % HKV == 0 && QOFF >= 0 && QOFF + SQ <= SKV && WINDOW >= 1, "geometry");

using bf16 = __hip_bfloat16;
typedef short bf16x8 __attribute__((ext_vector_type(8)));
typedef short s16x4 __attribute__((ext_vector_type(4)));
typedef float f32x16 __attribute__((ext_vector_type(16)));
typedef float f32x4 __attribute__((ext_vector_type(4)));
typedef unsigned u32x4 __attribute__((ext_vector_type(4)));
template <class A, class Bt> struct same_t { static constexpr bool v = false; };
template <class A> struct same_t<A, A> { static constexpr bool v = true; };

#define KSWZ(row, colB) ((row) * 256 + ((colB) ^ (((row) & 7) << 4)))
#define SBAR() __builtin_amdgcn_sched_barrier(0)
__device__ __forceinline__ int v_st(int k, int c) { const int kk = (k & ~0xC) | ((k & 4) << 1) | ((k & 8) >> 1); return ((kk >> 3) * 4 + (c >> 5)) * 512 + ((kk & 7) * 32 + (c & 31)) * 2; }
__device__ __forceinline__ int v_rd_base(int lane) { return ((lane & 3) << 3) | (((lane >> 2) & 3) << 6) | (((lane >> 4) & 1) << 5) | (((lane >> 5) & 1) << 8); }
constexpr int v_rd_off(int d0, int ks, int half) { return d0 * 512 + ks * 4096 + half * 2048; }
__device__ __forceinline__ int crow(int r, int hi) { return (r & 3) + 8 * (r >> 2) + 4 * hi; }
__device__ __forceinline__ unsigned cvtpk(float lo, float hi) {
    unsigned r; asm volatile("s_nop 0\n\tv_cvt_pk_bf16_f32 %0, %1, %2" : "=v"(r) : "v"(lo), "v"(hi)); return r;
}
__device__ __forceinline__ bf16x8 pack8(f32x4 a, f32x4 b) {
    u32x4 w = {cvtpk(a[0], a[1]), cvtpk(a[2], a[3]), cvtpk(b[0], b[1]), cvtpk(b[2], b[3])};
    return *reinterpret_cast<bf16x8*>(&w);
}
template <class T> __device__ __forceinline__ bf16x8 load8(const T* p) {
    if constexpr (same_t<T, float>::v) { return pack8(*(const f32x4*)p, *(const f32x4*)(p + 4)); }
    else { return *reinterpret_cast<const bf16x8*>(p); }
}
__device__ __forceinline__ void mask_tile(f32x16& p0, f32x16& p1, int dq, unsigned W) {
    const float NEG = -__builtin_inff();
#pragma unroll
    for (int r = 0; r < 16; ++r) {
        const int c = (r & 3) + 8 * (r >> 2);
        if ((unsigned)(dq - c) >= W) p0[r] = NEG;
        if ((unsigned)(dq - c - 32) >= W) p1[r] = NEG;
    }
}
__device__ __forceinline__ void partialSM(f32x16& p0, f32x16& p1, float& m_reg, float& mn, float& alpha) {
    float pmax = p0[0]; for (int r = 1; r < 16; ++r) pmax = fmaxf(pmax, p0[r]); for (int r = 0; r < 16; ++r) pmax = fmaxf(pmax, p1[r]);
    { auto rr = __builtin_amdgcn_permlane32_swap(__float_as_uint(pmax), __float_as_uint(pmax), false, false);
      pmax = fmaxf(__uint_as_float(rr[0]), __uint_as_float(rr[1])); }
    constexpr float C2 = 1.4426950408889634f * SCALE;
    if (__builtin_expect(__all((pmax - m_reg) * SCALE <= THR), 1)) { mn = m_reg; alpha = 1.f; }
    else { mn = fmaxf(m_reg, pmax); alpha = __builtin_amdgcn_exp2f((m_reg - mn) * C2); m_reg = mn; }
    const float mnL = -mn * C2;
    for (int r = 0; r < 16; ++r) p0[r] = fmaf(p0[r], C2, mnL); for (int r = 0; r < 16; ++r) p1[r] = fmaf(p1[r], C2, mnL);
    for (int r = 0; r < 16; ++r) p0[r] = __builtin_amdgcn_exp2f(p0[r]);
}
__device__ __forceinline__ void finishSM(f32x16& p0, f32x16& p1, float alpha, float& l_reg, bf16x8& pa0, bf16x8& pa1, bf16x8& pa2, bf16x8& pa3) {
    for (int r = 0; r < 16; ++r) p1[r] = __builtin_amdgcn_exp2f(p1[r]);
    float ps = 0; for (int r = 0; r < 16; ++r) ps += p0[r]; for (int r = 0; r < 16; ++r) ps += p1[r];
    { auto rr = __builtin_amdgcn_permlane32_swap(__float_as_uint(ps), __float_as_uint(ps), false, false);
      ps = __uint_as_float(rr[0]) + __uint_as_float(rr[1]); }
    l_reg = l_reg * alpha + ps;
#define PK4(P, B_, OUT) do { unsigned a0 = cvtpk(P[B_+0], P[B_+1]), a1 = cvtpk(P[B_+2], P[B_+3]);                          \
        unsigned b0 = cvtpk(P[B_+4], P[B_+5]), b1 = cvtpk(P[B_+6], P[B_+7]);                                             \
        auto r0 = __builtin_amdgcn_permlane32_swap(a0, b0, false, false); auto r1 = __builtin_amdgcn_permlane32_swap(a1, b1, false, false); \
        u32x4 w = {r0[0], r1[0], r0[1], r1[1]}; OUT = *reinterpret_cast<bf16x8*>(&w); } while (0)
    PK4(p0, 0, pa0); PK4(p0, 8, pa1); PK4(p1, 0, pa2); PK4(p1, 8, pa3);
#undef PK4
}
template <int KB, bool SK>
__device__ __forceinline__ void qkt(f32x16& p0, f32x16& p1, const char* K_lds, int r32, int hi, const bf16x8* qr, bool act, const __attribute__((address_space(3))) float* csk) {
    if (SK && !act) { const float NEG = -__builtin_inff();
#pragma unroll
        for (int r = 0; r < 16; ++r) { p0[r] = NEG; p1[r] = NEG; } return; }
    {
        typedef __attribute__((address_space(3))) f32x4 lf4; const lf4* cb = (const lf4*)(csk + 4 * hi);
        const f32x4 a0 = cb[0], a1 = cb[2], a2 = cb[4], a3 = cb[6], b0 = cb[8], b1 = cb[10], b2 = cb[12], b3 = cb[14];
        p0 = __builtin_shufflevector(__builtin_shufflevector(a0, a1, 0, 1, 2, 3, 4, 5, 6, 7), __builtin_shufflevector(a2, a3, 0, 1, 2, 3, 4, 5, 6, 7), 0, 1, 2, 3, 4, 5, 6, 7, 8, 9, 10, 11, 12, 13, 14, 15);
        p1 = __builtin_shufflevector(__builtin_shufflevector(b0, b1, 0, 1, 2, 3, 4, 5, 6, 7), __builtin_shufflevector(b2, b3, 0, 1, 2, 3, 4, 5, 6, 7), 0, 1, 2, 3, 4, 5, 6, 7, 8, 9, 10, 11, 12, 13, 14, 15); }
    const char* kb[4];
#pragma unroll
    for (int dd = 0; dd < 4; ++dd) kb[dd] = K_lds + KB * SHM_K + KSWZ(r32, (dd * 16 + hi * 8) * 2);
#pragma unroll
    for (int d0 = 0; d0 < 8; ++d0) { const char* a = kb[d0 & 3] + (d0 >> 2) * 128;
        bf16x8 b0 = *reinterpret_cast<const bf16x8*>(a);
        bf16x8 b1 = *reinterpret_cast<const bf16x8*>(a + 32 * 256);
        p0 = __builtin_amdgcn_mfma_f32_32x32x16_bf16(b0, qr[d0], p0, 0, 0, 0);
        p1 = __builtin_amdgcn_mfma_f32_32x32x16_bf16(b1, qr[d0], p1, 0, 0, 0); }
}
template <int VB, bool SK>
__device__ __forceinline__ void pv_tile(f32x16* o, int vb0, bf16x8 pa0, bf16x8 pa1, bf16x8 pa2, bf16x8 pa3, bool act) {
    if (SK && !act) return;
#define TRRD(dst, off) asm volatile("ds_read_b64_tr_b16 %0, %1 offset:%2" : "=&v"(dst) : "v"(vb0), "i"(off) : "memory")
#define PV_D0(d0) do { s16x4 l0, l1, l2, l3, h0, h1, h2, h3; constexpr int b_ = VB * SHM_V + v_rd_off(d0, 0, 0);     \
        TRRD(l0, b_); TRRD(h0, b_ + 2048); TRRD(l1, b_ + 4096); TRRD(h1, b_ + 6144); TRRD(l2, b_ + 8192); TRRD(h2, b_ + 10240); TRRD(l3, b_ + 12288); TRRD(h3, b_ + 14336); \
        asm volatile("s_waitcnt lgkmcnt(0)" ::: "memory"); SBAR();                 \
        o[d0] = __builtin_amdgcn_mfma_f32_32x32x16_bf16(pa0, (bf16x8){l0[0], l0[1], l0[2], l0[3], h0[0], h0[1], h0[2], h0[3]}, o[d0], 0, 0, 0);   \
        o[d0] = __builtin_amdgcn_mfma_f32_32x32x16_bf16(pa1, (bf16x8){l1[0], l1[1], l1[2], l1[3], h1[0], h1[1], h1[2], h1[3]}, o[d0], 0, 0, 0);   \
        o[d0] = __builtin_amdgcn_mfma_f32_32x32x16_bf16(pa2, (bf16x8){l2[0], l2[1], l2[2], l2[3], h2[0], h2[1], h2[2], h2[3]}, o[d0], 0, 0, 0);   \
        o[d0] = __builtin_amdgcn_mfma_f32_32x32x16_bf16(pa3, (bf16x8){l3[0], l3[1], l3[2], l3[3], h3[0], h3[1], h3[2], h3[3]}, o[d0], 0, 0, 0); } while (0)
    PV_D0(0); PV_D0(1); PV_D0(2); PV_D0(3);
#undef PV_D0
#undef TRRD
}

template <class TIn, class TOut> struct BlockRef { const TIn* Q; const TIn* K; const TIn* V; TOut* O; int P0; float thr; };
template <class TIn> struct Seam {
    bf16x8 qr[8];
    bf16x8 st_v0, st_v1, st_k0, st_k1; f32x4 sf0, sf1, sf2, sf3;
    f32x4 tq[16];
};
__device__ __forceinline__ int swa_jlo(int P0, int W) { const int lowk = P0 - W + 1; return lowk > 0 ? lowk / KVBLK : 0; }
__device__ __forceinline__ int fox_jlo(const __attribute__((address_space(3))) float* ncs, int P0, float thr) {
    int l = threadIdx.x; asm volatile("" : "+v"(l)); l &= 63;
    float e = 3.2086e-10f * __expf(fminf((thr - (ncs[P0] - ncs[64 * l + 63])) * 0.08838834764831845f, 80.f));
#pragma unroll
    for (int o = 1; o < 64; o <<= 1) { const float u = pg8::shfl_up_l(e, o, l); e += (l >= o) ? u : 0.f; }
    return __builtin_amdgcn_readfirstlane(__builtin_ctzll(__ballot(e >= 3e-8f)));
}
#define ROW(p, k0, rr) ((p) + (size_t)((k0) + (rr)) * D + sc)
#define VMW() asm volatile("s_waitcnt vmcnt(0)" ::: "memory")
#define VMWN(n) asm volatile("s_waitcnt vmcnt(%0)" :: "i"(n) : "memory")
#define SLOAD_H(Kp, Vp, k0) do { S.st_v0 = load8<TIn>(ROW(Vp, k0, sr)); S.st_v1 = load8<TIn>(ROW(Vp, k0, 32 + sr));              \
                         S.st_k0 = load8<TIn>(ROW(Kp, k0, sr)); S.st_k1 = load8<TIn>(ROW(Kp, k0, 32 + sr)); } while (0)
#define SWRITE_HK(bf) do { *(bf16x8*)(K_lds + (bf) * SHM_K + kws) = S.st_k0; *(bf16x8*)(K_lds + (bf) * SHM_K + kws + 32 * 256) = S.st_k1; } while (0)
#define SWRITE_HV(bf) do { *(bf16x8*)(V_lds + (bf) * SHM_V + vst0) = S.st_v0; *(bf16x8*)(V_lds + (bf) * SHM_V + vst1) = S.st_v1; } while (0)
#define SWRITE_H(bf) do { SWRITE_HV(bf); SWRITE_HK(bf); } while (0)
#define SLOAD_F(p, k0) do { S.sf0 = *(const f32x4*)ROW(p, k0, sr); S.sf1 = *(const f32x4*)(ROW(p, k0, sr) + 4);                \
                            S.sf2 = *(const f32x4*)ROW(p, k0, 32 + sr); S.sf3 = *(const f32x4*)(ROW(p, k0, 32 + sr) + 4); } while (0)
#define SWRITE_KF(bf) do { *(bf16x8*)(K_lds + (bf) * SHM_K + kws) = pack8(S.sf0, S.sf1); *(bf16x8*)(K_lds + (bf) * SHM_K + kws + 32 * 256) = pack8(S.sf2, S.sf3); } while (0)
#define SWRITE_VF(bf) do { *(bf16x8*)(V_lds + (bf) * SHM_V + vst0) = pack8(S.sf0, S.sf1); *(bf16x8*)(V_lds + (bf) * SHM_V + vst1) = pack8(S.sf2, S.sf3); } while (0)
template <class TIn, class TOut>
__device__ __forceinline__ void causal_swa_prime(const BlockRef<TIn, TOut>& cur, int W, char* lds, Seam<TIn>& S, const __attribute__((address_space(3))) float* ncs) {
    constexpr bool F32 = same_t<TIn, float>::v;
    int tid_ = threadIdx.x; asm volatile("" : "+v"(tid_));
    const int tid = tid_, wid = __builtin_amdgcn_readfirstlane(tid >> 6), lane = tid & 63, r32 = lane & 31, hi = lane >> 5;
    const int sr = tid >> 4, sc = (tid & 15) * 8, kws = KSWZ(sr, sc * 2); char* K_lds = lds + 2 * SHM_V;
    const int kb0 = fox_jlo(ncs, cur.P0, cur.thr) * KVBLK;
    for (int d0 = 0; d0 < 8; ++d0) S.qr[d0] = load8<TIn>(cur.Q + (size_t)(wid * QBLK + r32) * D + d0 * 16 + hi * 8);
    if constexpr (F32) { SLOAD_F((const float*)cur.K, kb0); VMW(); SWRITE_KF(0); SBAR(); SLOAD_F((const float*)cur.V, kb0); }
    else { SLOAD_H(cur.K, cur.V, kb0); VMW(); SWRITE_HK(0); }
    __syncthreads();
}
template <class TIn, class TOut>
__device__ __forceinline__ void causal_swa_block(const BlockRef<TIn, TOut>& cur, const BlockRef<TIn, TOut>& nxt, int skv, int W, char* lds, Seam<TIn>& S, const __attribute__((address_space(3))) float* cs, long gdelta) {
    constexpr bool F32 = same_t<TIn, float>::v;
    int tid_ = threadIdx.x; asm volatile("" : "+v"(tid_));
    const int tid = tid_, wid = __builtin_amdgcn_readfirstlane(tid >> 6), lane = tid & 63, r32 = lane & 31, hi = lane >> 5;
    const int j_lo = fox_jlo(cs, cur.P0, cur.thr);
    int j_hi = (cur.P0 + QB - 1) / KVBLK + 1; if (j_hi > skv / KVBLK) j_hi = skv / KVBLK;
    const int NT = j_hi - j_lo;
    const int kbn = fox_jlo(cs, nxt.P0, nxt.thr) * KVBLK;
    const int qlo = cur.P0 + wid * QBLK, qm = qlo + r32 - 4 * hi;
    char* V_lds = lds; char* K_lds = lds + 2 * SHM_V;
    float* ws = (float*)(lds + 2 * SHM_V + 2 * SHM_K) + wid * 64; float* li_l = ws, * al_l = ws + 32;
    float m_reg = -1e30f, l_reg = 0; f32x16 o[4] = {};
    const int sr = tid >> 4, sc = (tid & 15) * 8, vst0 = v_st(sr, sc), vst1 = v_st(32 + sr, sc), kws = KSWZ(sr, sc * 2);
    const int vb0 = (int)(uintptr_t)V_lds + v_rd_base(lane);
    const TIn* Kh = cur.K; const TIn* Vh = cur.V;
#define RESC(a) do { if (__any((a) < 1.f)) { if (hi == 0) al_l[r32] = (a); asm volatile("s_waitcnt lgkmcnt(0)" ::: "memory");              \
                     for (int d_ = 0; d_ < 4; ++d_) for (int r = 0; r < 16; ++r) o[d_][r] *= al_l[crow(r, hi)]; } } while (0)
#define KBASE(t) ((j_lo + (t)) * KVBLK)
#define ACT(t) (KBASE(t) <= qlo + QBLK - 1 && KBASE(t) + KVBLK - 1 >= qlo - W + 1)
#define MASKT(P0_, P1_, t) do { const int kb_ = KBASE(t); if ((!SK || ACT(t)) && (kb_ + KVBLK - 1 > qlo || kb_ <= qlo + QBLK - 1 - W)) mask_tile(P0_, P1_, qm - kb_, (unsigned)W); } while (0)
    constexpr int NQL = F32 ? 16 : 8;
    constexpr bool SK = WSKIP && !F32;
#define SEAM_K0() do { VMWN(NQL); if constexpr (F32) { SWRITE_KF(0); SBAR(); SLOAD_F((const float*)nxt.V, kbn); } else { SWRITE_HK(0); } SBAR(); } while (0)
    f32x16 pA0, pA1, pB0, pB1; float mnA, mnB, alA, alB; bf16x8 pa0, pa1, pa2, pa3;
    if constexpr (F32) { VMW(); SWRITE_VF(0); SBAR(); } else { SWRITE_HV(0); SBAR(); }
    if (NT > 1) { if constexpr (F32) SLOAD_F((const float*)Kh, KBASE(1)); else SLOAD_H(Kh, Vh, KBASE(1)); }
    SBAR(); qkt<0, SK>(pA0, pA1, K_lds, r32, hi, S.qr, ACT(0), cs + KBASE(0));
    if constexpr (F32) { if (NT > 1) { VMW(); SWRITE_KF(1); SBAR(); SLOAD_F((const float*)Vh, KBASE(1)); } }
    MASKT(pA0, pA1, 0); partialSM(pA0, pA1, m_reg, mnA, alA);
    if (NT > 1) { VMW(); if constexpr (F32) { SWRITE_VF(1); SBAR(); if (NT > 2) SLOAD_F((const float*)Kh, KBASE(2)); } else SWRITE_H(1); }
    __syncthreads();
#define HALF_STEP(PX0, PX1, mnX, alX, PY0, PY1, alY, t, KB, VB, SB) do {                                                      \
        SBAR(); qkt<KB, SK>(PX0, PX1, K_lds, r32, hi, S.qr, ACT(t), cs + KBASE(t));                                             \
        finishSM(PY0, PY1, alY, l_reg, pa0, pa1, pa2, pa3); SBAR();                                                           \
        if ((t) + 1 < NT) { if constexpr (F32) { VMW(); SWRITE_KF(SB); SBAR(); SLOAD_F((const float*)Vh, KBASE((t) + 1)); }  \
                            else { SLOAD_H(Kh, Vh, KBASE((t) + 1)); } SBAR(); }                                               \
        pv_tile<VB, SK>(o, vb0, pa0, pa1, pa2, pa3, ACT((t) - 1)); MASKT(PX0, PX1, (t)); partialSM(PX0, PX1, m_reg, mnX, alX);                                        \
        __syncthreads();                                                                                                      \
        if ((t) + 1 < NT) { VMW(); if constexpr (F32) { SWRITE_VF(SB); SBAR(); if ((t) + 2 < NT) SLOAD_F((const float*)Kh, KBASE((t) + 2)); } \
                            else { SWRITE_H(SB); } }                                                                          \
        RESC(alX); __syncthreads(); } while (0)
    for (int t = 1; t + 1 < NT; t += 2) {
        HALF_STEP(pB0, pB1, mnB, alB, pA0, pA1, alA, t, 1, 0, 0);
        HALF_STEP(pA0, pA1, mnA, alA, pB0, pB1, alB, t + 1, 0, 1, 1);
    }
    int tt_ = threadIdx.x; asm volatile("" : "+v"(tt_));
    const int widb = __builtin_amdgcn_readfirstlane(tt_ >> 6), laneb = tt_ & 63, r32b = laneb & 31, hib = laneb >> 5;
    const bool even = (NT & 1) == 0;
    if (even) { SBAR(); qkt<1, SK>(pB0, pB1, K_lds, r32, hi, S.qr, ACT(NT - 1), cs + KBASE(NT - 1)); SBAR(); }
#define QROW(e) (nxt.Q + (size_t)(wid * QBLK + r32) * D + ((e) >> 1) * 16 + hi * 8 + ((e) & 1) * 4)
    if constexpr (F32) { SLOAD_F((const float*)nxt.K, kbn); SBAR();
#pragma unroll
        for (int e = 0; e < 8; ++e) S.tq[e] = *(const f32x4*)QROW(e); }
    else { SLOAD_H(nxt.K, nxt.V, kbn); SBAR();
#pragma unroll
        for (int d0 = 0; d0 < 8; ++d0) S.qr[d0] = load8<TIn>(nxt.Q + (size_t)(widb * QBLK + r32b) * D + d0 * 16 + hib * 8); }
    SBAR();
    finishSM(pA0, pA1, alA, l_reg, pa0, pa1, pa2, pa3); SBAR();
    if constexpr (F32) {
#pragma unroll
        for (int e = 8; e < 16; ++e) S.tq[e] = *(const f32x4*)QROW(e); SBAR(); }
#undef QROW
    pv_tile<0, SK>(o, vb0, pa0, pa1, pa2, pa3, ACT(even ? NT - 2 : NT - 1));
    if (even) { MASKT(pB0, pB1, NT - 1); partialSM(pB0, pB1, m_reg, mnB, alB); __syncthreads(); RESC(alB);
        finishSM(pB0, pB1, alB, l_reg, pa0, pa1, pa2, pa3); SBAR(); pv_tile<1, SK>(o, vb0, pa0, pa1, pa2, pa3, ACT(NT - 1)); }
    SBAR(); SEAM_K0();
    float* li_b = (float*)(lds + 2 * SHM_V + 2 * SHM_K) + widb * 64;
    if (hib == 0) li_b[r32b] = l_reg; asm volatile("s_waitcnt lgkmcnt(0)" ::: "memory");
    float rli[16];
#pragma unroll
    for (int r = 0; r < 16; ++r) rli[r] = __builtin_amdgcn_rcpf(li_b[crow(r, hib)]);
    {
        typedef __attribute__((address_space(3))) unsigned short lus; typedef __attribute__((address_space(3))) u32x4 lu4;
        const unsigned ost = (unsigned)(uintptr_t)lds + OST_OFF + widb * 8192;
#pragma unroll
        for (int r = 0; r < 16; ++r) { const int orow = crow(r, hib);
#pragma unroll
            for (int d0 = 0; d0 < 4; ++d0) { const float v = o[d0][r] * rli[r]; const unsigned w = cvtpk(v, v);
                *(lus*)(ost + orow * 256 + (d0 * 32 + r32b) * 2) = (unsigned short)w; } }
        asm volatile("s_waitcnt lgkmcnt(0)" ::: "memory");
        TOut* Ow = cur.O + (size_t)(widb * QBLK) * OP; const char* Gw = (const char*)Ow + gdelta;
#pragma unroll
        for (int half = 0; half < 2; ++half) { u32x4 ov[4], gv[4];
#pragma unroll
            for (int i = 0; i < 4; ++i) { const int ci = laneb + 64 * (4 * half + i), row = ci >> 4, ch = ci & 15; ov[i] = *(const lu4*)(ost + row * 256 + ch * 16); gv[i] = *(const u32x4*)(Gw + ((size_t)row * OP + ch * 8) * 2); }
#pragma unroll
            for (int i = 0; i < 4; ++i) { const int ci = laneb + 64 * (4 * half + i), row = ci >> 4, ch = ci & 15; u32x4 w;
#pragma unroll
                for (int e = 0; e < 4; ++e) { const float a0 = __uint_as_float(ov[i][e] << 16) * __uint_as_float(gv[i][e] << 16), a1 = __uint_as_float(ov[i][e] & 0xffff0000u) * __uint_as_float(gv[i][e] & 0xffff0000u); w[e] = cvtpk(a0, a1); }
                *(u32x4*)((char*)Ow + ((size_t)row * OP + ch * 8) * 2) = w; } }
    }
    if constexpr (F32) {
#pragma unroll
        for (int d0 = 0; d0 < 8; ++d0) S.qr[d0] = pack8(S.tq[2 * d0], S.tq[2 * d0 + 1]); }
    __syncthreads();
#undef RESC
#undef KBASE
#undef ACT
#undef MASKT
#undef SEAM_K0
#undef HALF_STEP
}
#undef ROW
#undef VMW
#undef VMWN
#undef SLOAD_H
#undef SWRITE_HK
#undef SWRITE_HV
#undef SWRITE_H
#undef SLOAD_F
#undef SWRITE_KF
#undef SWRITE_VF

__host__ __device__ inline int swa_nramp(int nqb, int W, int qoff) { const int t = W - 1 - qoff; const int n = t < 0 ? 0 : t / QB + 1; return n > nqb ? nqb : n; }
__host__ __device__ inline int swa_nx(int nqb, int nramp, int order) { return (order & ORDER_PAIRED) ? (nramp + 1) / 2 + (nqb - nramp) : nqb; }
struct SwaItem { int bh, qb0, qb1; };
__device__ __forceinline__ SwaItem swa_decode(int L, int nqb, int nx, int nramp) {
    SwaItem it; it.bh = L / nx; const int x = L - it.bh * nx; const int ns = nqb - nramp;
    if (x < ns) { it.qb0 = it.qb1 = nqb - 1 - x; } else { it.qb0 = x - ns; it.qb1 = nramp - 1 - it.qb0; }
    return it;
}
}
constexpr int NWAVES = 8;
#ifndef MK_N_LAUNCHES
#define MK_N_LAUNCHES 1
#endif
constexpr int DM = 2048, NBATCH = 4, SEQ = 4096, M = NBATCH * SEQ, DEPTH = 4, HD = 128, DH = 1024, EVEN_IN = 8192, ODD_IN = 8208, NFOX = 16, DFF = 5504, DFF2 = 2 * DFF;
constexpr int NUNITS = 64 * 64;
constexpr size_t MiB = 1u << 20;
constexpr size_t WS_CTL = 0, CTL_ZERO_BYTES = 1 * MiB;
constexpr size_t WS_RSP = 2 * MiB;
constexpr size_t WS_LF = 4 * MiB;
constexpr size_t WS_DEC = 5 * MiB;
constexpr size_t WS_WF = 7 * MiB;
constexpr size_t WS_WIE = 8 * MiB, WS_WOE = 72 * MiB, WS_WIO = 88 * MiB, WS_WOO = 152 * MiB, WS_WU = 168 * MiB, WS_WD = 340 * MiB;
constexpr size_t WS_XB = 426 * MiB;
constexpr size_t WS_OB = 490 * MiB;
constexpr size_t WS_PROJ = 554 * MiB;
constexpr size_t WS_KV = WS_PROJ + 256 * MiB;
constexpr size_t WS_ACT = 898 * MiB;
constexpr size_t WS_LOGF = 1070 * MiB;
constexpr size_t WS_ST = 1134 * MiB;
constexpr size_t WS_SB = 1262 * MiB;
constexpr size_t WS_END = 1274 * MiB;
static_assert(WS_WD + 4 * (size_t)DM * DFF * 2 <= WS_XB && WS_PROJ + (size_t)M * DFF2 * 2 <= WS_ACT && WS_KV + (size_t)NUNITS * 16384 * 4 <= WS_LOGF && WS_ACT + (size_t)M * DFF * 2 <= WS_LOGF, "ws map");
constexpr int CW_TMO = 0, CW_BAR = 4096, CW_NRM = 8192, CW_CONVQ = 9216  ;
constexpr int RING_BYTES = 131072, CS_OFF = fox::OST_OFF + fox::OST_BYTES  , CS_BYTES = 16384 + 64, MISC_OFF = CS_OFF + CS_BYTES, LDS_BYTES = MISC_OFF + 448;
static_assert(CS_OFF >= RING_BYTES, "lds map");
static_assert(LDS_BYTES <= 160 * 1024 && LDS_BYTES > 80 * 1024, "one workgroup per CU");

#define GAS __attribute__((address_space(1)))
#define LAS __attribute__((address_space(3)))
typedef unsigned short bf16;
typedef unsigned v4u __attribute__((ext_vector_type(4)));
typedef unsigned v2u __attribute__((ext_vector_type(2)));
typedef float f32x4 __attribute__((ext_vector_type(4)));
typedef float f32x2 __attribute__((ext_vector_type(2)));
typedef short bf16x8 __attribute__((ext_vector_type(8)));
#define LDS_WAIT() asm volatile("s_waitcnt lgkmcnt(0)" ::: "memory")
#define VM_WAIT() asm volatile("s_waitcnt vmcnt(0)" ::: "memory")
__device__ __forceinline__ unsigned f2bf(float f) { unsigned u = __builtin_bit_cast(unsigned, f); return (u + 0x7fffu + ((u >> 16) & 1u)) >> 16; }
__device__ __forceinline__ unsigned pk2(float lo, float hi) { return pg8::cvt_pk_bf16_c(lo, hi); }
__device__ __forceinline__ float bf2f(unsigned short b) { return __builtin_bit_cast(float, (unsigned)b << 16); }
__device__ __forceinline__ float bflo(unsigned w) { return __builtin_bit_cast(float, w << 16); }
__device__ __forceinline__ float bfhi(unsigned w) { return __builtin_bit_cast(float, w & 0xffff0000u); }
__device__ __forceinline__ float wave_sum(float v) {
    const int l_ = pg8::lane_now();
#pragma unroll
    for (int o = 1; o < 64; o <<= 1) v += pg8::shfl_xor_l(v, o, l_);
    return v;
}
#define XB_TMO      128
#define XB_XCNT(j)  (256  + 64 * (j))
#define XB_XSUB(j)  (1280 + 64 * (j))
#define XB_XGEN(j)  (2304 + 64 * (j))
#define XB_TOP      3328
#define XB_TOPGEN   3392
#define XCD_BAR_WORDS 3456
#define XB_SPIN_CAP (1u << 18)

__device__ __forceinline__ unsigned xb_ld(unsigned* p)              { return __hip_atomic_load(p, __ATOMIC_RELAXED, __HIP_MEMORY_SCOPE_AGENT); }
__device__ __forceinline__ unsigned xb_add(unsigned* p, unsigned v) { return __hip_atomic_fetch_add(p, v, __ATOMIC_RELAXED, __HIP_MEMORY_SCOPE_AGENT); }
__device__ __forceinline__ unsigned xb_xcc_id() { return (unsigned)__builtin_amdgcn_s_getreg((3 << 11) | 20) & 0xFu; }
#define XB_SPIN(cond, bar) do { unsigned _sp = 0; while (cond) { __builtin_amdgcn_s_sleep(1); \
    if ((++_sp & 255u) == 0u) { if (xb_ld(&(bar)[XB_TMO])) break; if (_sp > XB_SPIN_CAP) { atomicAdd(&(bar)[XB_TMO], 1u); break; } } } } while (0)

struct XcdBarrier {
    unsigned* bar; unsigned x;
    volatile LAS unsigned* st;
};

__device__ __forceinline__ XcdBarrier xcd_barrier_post(unsigned* bar, volatile LAS unsigned* st) {
    XcdBarrier b; b.bar = bar; b.x = xb_xcc_id(); b.st = st;
    if (threadIdx.x == 0) (void)xb_add(&bar[XB_XCNT(b.x)], 1u);
    return b;
}
__device__ __forceinline__ void xcd_barrier_complete(unsigned* bar, unsigned x, unsigned& nloc, unsigned& nx) {
    const unsigned G = gridDim.x * gridDim.y * gridDim.z;
    unsigned sum, cnt, mine, sp = 0u;
    for (;;) {
        sum = 0u; cnt = 0u; mine = 0u;
#pragma unroll
        for (unsigned j = 0; j < 16; ++j) { const unsigned c = xb_ld(&bar[XB_XCNT(j)]); sum += c; cnt += (c > 0u) ? 1u : 0u; mine = (j == x) ? c : mine; }
        if (sum == G) break;
        __builtin_amdgcn_s_sleep(1);
        if ((++sp & 255u) == 0u) { if (xb_ld(&bar[XB_TMO])) break; if (sp > XB_SPIN_CAP) { atomicAdd(&bar[XB_TMO], 1u); break; } }
    }
    nloc = mine > 0u ? mine : 1u; nx = cnt > 0u ? cnt : 1u;
}

__device__ __forceinline__ void xcd_barrier(const XcdBarrier& b) {
    asm volatile("s_waitcnt vmcnt(0)" ::: "memory");
    __syncthreads();
    if (threadIdx.x == 0) {
        unsigned* bar = b.bar;
        __builtin_amdgcn_s_waitcnt(0);
        unsigned nloc = b.st[0], nx = b.st[1];
        if (nloc == 0u) { xcd_barrier_complete(bar, b.x, nloc, nx); b.st[0] = nloc; b.st[1] = nx; }
        const unsigned old = xb_add(&bar[XB_XSUB(b.x)], 1u);
        const unsigned gen = old / nloc;
        if (old + 1u == (gen + 1u) * nloc) {
            __builtin_amdgcn_fence(__ATOMIC_RELEASE, "agent");
            asm volatile("s_waitcnt vmcnt(0)" ::: "memory");
            const unsigned og = xb_add(&bar[XB_TOP], 1u);
            const unsigned tg = og / nx;
            if (og + 1u == (tg + 1u) * nx) xb_add(&bar[XB_TOPGEN], 1u);
            else XB_SPIN(xb_ld(&bar[XB_TOPGEN]) == tg, bar);
            __builtin_amdgcn_fence(__ATOMIC_ACQUIRE, "agent");
            xb_add(&bar[XB_XGEN(b.x)], 1u);
            asm volatile("s_waitcnt vmcnt(0)" ::: "memory");
        } else {
            XB_SPIN(xb_ld(&bar[XB_XGEN(b.x)]) == gen, bar);
            __builtin_amdgcn_fence(__ATOMIC_ACQUIRE, "agent");
            asm volatile("s_waitcnt vmcnt(0)" ::: "memory");
        }
    }
    __syncthreads();
}
struct Ctx { LAS unsigned char* lds; int tid, lane, wave, vcu, G, bx; };

__device__ __forceinline__ int src_col(int n, int mode) {
    if (mode == 1 && (n >> 10) >= 4 && (n >> 10) <= 5) { const int p = n & 127; return (n & ~127) + (p >> 1) + 64 * (p & 1); }
    if (mode == 2) return ((n >> 7) & 1) * DFF + (n >> 8) * 128 + (n & 127);
    return n;
}
template <bool NT = false, int KB = 64>
__device__ __forceinline__ void transpose_item(const float* W, int ldw, int K, int N, const float* nw, int mode, bf16* WT, LAS float* scr, int item, int lane) {
    const int nblk = N / 32, kb = item / nblk, nb = item - kb * nblk, k0 = KB * kb, n0 = 32 * nb;
    const int sc = src_col(n0 + (lane & 31), mode);
    float wv[KB / 2];
#pragma unroll
    for (int i = 0; i < KB / 2; ++i) { const float* p_ = W + (size_t)(k0 + 2 * i + (lane >> 5)) * ldw + sc; wv[i] = NT ? __builtin_nontemporal_load(p_) : *p_; }
    if (nw) {
#pragma unroll
        for (int i = 0; i < KB / 2; ++i) wv[i] *= nw[k0 + 2 * i + (lane >> 5)]; }
#pragma unroll
    for (int i = 0; i < KB / 2; ++i) scr[(2 * i + (lane >> 5)) * 33 + (lane & 31)] = wv[i];
    LDS_WAIT(); asm volatile("" ::: "memory");
    const int c = lane & 7;
#pragma unroll
    for (int kk = 0; kk < KB / 64; ++kk)
#pragma unroll
        for (int j = 0; j < 4; ++j) { const int n = (lane >> 3) + 8 * j; const LAS float* s = scr + (64 * kk + 8 * c) * 33 + n;
            v4u o; o.x = pk2(s[0 * 33], s[1 * 33]); o.y = pk2(s[2 * 33], s[3 * 33]); o.z = pk2(s[4 * 33], s[5 * 33]); o.w = pk2(s[6 * 33], s[7 * 33]);
            bf16* dst = WT + (size_t)(n0 + n) * K + k0 + 64 * kk + 8 * c;
            if (NT) __builtin_nontemporal_store(o, (GAS v4u*)dst); else *(GAS v4u*)dst = o; }
    LDS_WAIT(); asm volatile("" ::: "memory");
}
__device__ __forceinline__ void p0_prologue(const Ctx& C, const float* const* in, unsigned char* ws, float* rs0) {
    LAS float* scr = (LAS float*)(C.lds + C.wave * 16384);
    const int gw = C.vcu * NWAVES + C.wave, NGW = C.G * NWAVES;
    int start = gw;
#define TR(Wp, ldw, K, N, nwp, mode, WTp) do { const int nit_ = ((K) / 64) * ((N) / 32); int it_ = start; for (; it_ < nit_; it_ += NGW) transpose_item(Wp, ldw, K, N, nwp, mode, WTp, scr, it_, C.lane); start = it_ - nit_; } while (0)
    TR(in[4], EVEN_IN, DM, EVEN_IN, in[1], 1, (bf16*)(ws + WS_WIE));
    TR(in[8], DM, DM, DM, (const float*)nullptr, 0, (bf16*)(ws + WS_WOE));
    for (int l = 0; l < 2; ++l) {
        TR(in[12] + (size_t)l * DM * DFF2, DFF2, DM, DFF2, in[2] + l * DM, 2, (bf16*)(ws + WS_WU) + (size_t)l * DFF2 * DM);
        TR(in[14] + (size_t)l * DFF * DM, DM, DFF, DM, (const float*)nullptr, 0, (bf16*)(ws + WS_WD) + (size_t)l * DM * DFF);
    }
#undef TR
    { bf16* WF = (bf16*)(ws + WS_WF);
      for (int i = C.vcu * 512 + C.tid; i < 2 * 16 * DM; i += C.G * 512) { const int j = i >> 15, o = (i >> 11) & 15, k = i & 2047;
          WF[i] = (bf16)f2bf(in[9][((size_t)j * DM + k) * ODD_IN + 8192 + o] * in[1][(2 * j + 1) * DM + k]); } }
    { const float* x = in[0]; bf16* XB = (bf16*)(ws + WS_XB);
      for (int m = gw; m < M; m += NGW) { const GAS f32x4* xr = (const GAS f32x4*)(x + (size_t)m * DM) + C.lane; GAS v2u* o8 = (GAS v2u*)(XB + (size_t)m * DM) + C.lane; float s = 0.f;
#pragma unroll
          for (int q = 0; q < 8; ++q) { const f32x4 v = xr[64 * q]; s += (v.x * v.x + v.y * v.y) + (v.z * v.z + v.w * v.w); v2u w; w.x = pk2(v.x, v.y); w.y = pk2(v.z, v.w); o8[64 * q] = w; }
          s = wave_sum(s); if (C.lane < 32) rs0[(size_t)m * 32 + C.lane] = C.lane == 0 ? s : 0.f; } }
}
__device__ __forceinline__ void prep_rstd(const Ctx& C, const float* rs, int pm0, LAS float* tab) {
    if (C.tid < 256) { const float* p = rs + ((size_t)pm0 * 256 + C.tid) * 32; float s = 0.f;
#pragma unroll
        for (int q = 0; q < 8; ++q) { const f32x4 v = *(const GAS f32x4*)(p + 4 * q); s += (v[0] + v[1]) + (v[2] + v[3]); }
        tab[C.tid] = __builtin_amdgcn_rsqf(s * (1.0f / (float)DM) + 1e-6f); }
    __syncthreads();
}
__device__ __forceinline__ void final_norm(const Ctx& C, const bf16* xb, float* out, const float* rs, const float* w) {
    const int gw = C.vcu * NWAVES + C.wave, NGW = C.G * NWAVES;
    for (int m = gw; m < M; m += NGW) { const GAS v2u* xr = (const GAS v2u*)(xb + (size_t)m * DM) + C.lane; GAS f32x4* orow = (GAS f32x4*)(out + (size_t)m * DM) + C.lane; const GAS f32x4* wr = (const GAS f32x4*)w + C.lane;
        const float rstd = __builtin_amdgcn_rsqf(wave_sum(C.lane < 32 ? rs[(size_t)m * 32 + C.lane] : 0.f) * (1.0f / (float)DM) + 1e-6f);
#pragma unroll
        for (int q = 0; q < 8; ++q) { const v2u x = xr[64 * q]; const f32x4 g = wr[64 * q]; orow[64 * q] = (f32x4){bflo(x.x) * rstd * g[0], bfhi(x.x) * rstd * g[1], bflo(x.y) * rstd * g[2], bfhi(x.y) * rstd * g[3]}; } }
}
__device__ __forceinline__ void flogit_phase(const Ctx& C, const bf16* xb, const bf16* wf, const float* rs, const float* bfv, float* lf) {
    const int fr = C.lane & 15, fq = C.lane >> 4, tw = C.wave >> 1, kh = C.wave & 1;
    LAS f32x4* red = (LAS f32x4*)C.lds;
    for (int tile = tw * C.G + C.vcu; tile < M / 16; tile += (NWAVES / 2) * C.G) {
        const GAS bf16x8* ap = (const GAS bf16x8*)(xb + (size_t)(tile * 16 + fr) * DM + kh * (DM / 2) + fq * 8); const GAS bf16x8* bp = (const GAS bf16x8*)(wf + (size_t)fr * DM + kh * (DM / 2) + fq * 8);
        f32x4 acc = {0.f, 0.f, 0.f, 0.f};
#pragma unroll 16
        for (int ks = 0; ks < DM / 64; ++ks) acc = __builtin_amdgcn_mfma_f32_16x16x32_bf16(ap[ks * 4], bp[ks * 4], acc, 0, 0, 0);
        __syncthreads();
        if (kh) red[tw * 64 + C.lane] = acc;
        __syncthreads();
        if (!kh) { acc += red[tw * 64 + C.lane];
            const float bias = bfv[fr];
#pragma unroll
            for (int r = 0; r < 4; ++r) { const int row = tile * 16 + 4 * fq + r; float ss = 0.f;
#pragma unroll
                for (int q = 0; q < 8; ++q) { const f32x4 p = *(const GAS f32x4*)(rs + (size_t)row * 32 + 4 * q); ss += (p[0] + p[1]) + (p[2] + p[3]); }
                const float v = acc[r] * __builtin_amdgcn_rsqf(ss * (1.0f / (float)DM) + 1e-6f) + bias;
                lf[(size_t)row * 16 + fr] = fminf(v, 0.f) - __logf(1.f + __expf(-fabsf(v))); } }
    }
}
__device__ __forceinline__ void unpack8(const v4u w, float (&f)[8]) { f[0] = bflo(w.x); f[1] = bfhi(w.x); f[2] = bflo(w.y); f[3] = bfhi(w.y); f[4] = bflo(w.z); f[5] = bfhi(w.z); f[6] = bflo(w.w); f[7] = bfhi(w.w); }
__device__ __forceinline__ void conv_fix(const Ctx& C, const float* sb, const float* cw, bf16* ACT) {
    constexpr int NCG = DFF / 8;
    for (int it = C.vcu * 512 + C.tid; it < 63 * NCG; it += C.G * 512) {
        const int pmi = it / NCG + 1, cg = it - (pmi - 1) * NCG, c0 = cg * 8, pn = c0 >> 7, w = c0 & 127;
        if ((pmi & 15) == 0) continue;
        float ug[4][8], uv[4][8];
#pragma unroll
        for (int r = 0; r < 4; ++r) { const float* sp = sb + (size_t)(r < 2 ? (pmi - 1) * 4 + 2 + r : pmi * 4 + (r - 2)) * DFF2 + pn * 256 + w;
            const f32x4 a = *(const GAS f32x4*)sp, b = *(const GAS f32x4*)(sp + 4), c = *(const GAS f32x4*)(sp + 128), d = *(const GAS f32x4*)(sp + 132);
#pragma unroll
            for (int e = 0; e < 4; ++e) { ug[r][e] = a[e]; ug[r][4 + e] = b[e]; uv[r][e] = c[e]; uv[r][4 + e] = d[e]; } }
        float o0[8], o1[8];
#pragma unroll
        for (int e = 0; e < 8; ++e) { const float g0w = cw[c0 + e], g1w = cw[DFF2 + c0 + e], g2w = cw[2 * DFF2 + c0 + e], v0w = cw[DFF + c0 + e], v1w = cw[DFF2 + DFF + c0 + e], v2w = cw[2 * DFF2 + DFF + c0 + e];
            const float ga = g0w * ug[0][e] + g1w * ug[1][e] + g2w * ug[2][e], va = v0w * uv[0][e] + v1w * uv[1][e] + v2w * uv[2][e];
            const float gb = g0w * ug[1][e] + g1w * ug[2][e] + g2w * ug[3][e], vb = v0w * uv[1][e] + v1w * uv[2][e] + v2w * uv[3][e];
            o0[e] = ga * pg8::fsigmoid(ga) * va; o1[e] = gb * pg8::fsigmoid(gb) * vb; }
        *(GAS v4u*)(ACT + (size_t)(pmi * 256) * DFF + c0) = pg8::pack8f(o0); *(GAS v4u*)(ACT + (size_t)(pmi * 256 + 1) * DFF + c0) = pg8::pack8f(o1);
    }
}
#define LBAR() asm volatile("s_waitcnt lgkmcnt(0)\n\ts_barrier" ::: "memory")
__device__ __forceinline__ void tile_ld(v4u (&r)[2], const bf16* src, int tid) {
#pragma unroll
    for (int i = 0; i < 2; ++i) r[i] = *(const GAS v4u*)(src + (size_t)(tid + 512 * i) * 8);
}
__device__ __forceinline__ void tile_st(LAS unsigned char* dst, const v4u (&r)[2], int tid) {
#pragma unroll
    for (int i = 0; i < 2; ++i) { const int idx = tid + 512 * i; *(LAS v4u*)(dst + (idx >> 4) * 272 + (idx & 15) * 16) = r[i]; }
}
typedef _Float16 lf16;
__device__ __forceinline__ void lf_ld(unsigned (&lf)[16], const lf16* lft, int c, int sg) {
#pragma unroll
    for (int i = 0; i < 16; ++i) lf[i] = *(const GAS unsigned short*)((const unsigned short*)lft + (16 * sg + i) * 128 + c);
}
__device__ __forceinline__ float lf_cv(unsigned w) { return (float)__builtin_bit_cast(lf16, (unsigned short)w); }
__device__ __forceinline__ void chunk_cumsum(float (&b)[16], float& blast, float& bmid, LAS float* segsum, int c, int sg) {
#pragma unroll
    for (int i = 1; i < 16; ++i) b[i] += b[i - 1];
    segsum[sg * 128 + c] = b[15];
    LBAR();
    const float s0 = segsum[c], s1 = segsum[128 + c], s2 = segsum[256 + c], s3 = segsum[384 + c];
    const float off = sg == 0 ? 0.f : (sg == 1 ? s0 : (sg == 2 ? s0 + s1 : s0 + s1 + s2));
#pragma unroll
    for (int i = 0; i < 16; ++i) b[i] += off;
    bmid = s0 + s1; blast = (s0 + s1) + (s2 + s3);
}
#define LFRAG(base, pitch, row, kk) (*(const LAS bf16x8*)((base) + (row) * (pitch) + (kk) * 2))
struct EUnit { int ret, h, hh; size_t m0, hoff; };
__device__ __forceinline__ EUnit e_unit(int unit) { EUnit u; const int chain = unit >> 6, n = unit & 63, b = chain >> 4; u.hh = chain & 15; u.ret = u.hh >> 3; u.h = u.hh & 7; u.m0 = (size_t)b * SEQ + n * 64; u.hoff = ((size_t)u.h * M + u.m0) * 128; return u; }
__device__ __forceinline__ void even_ea(const Ctx& C, const bf16* proj, const lf16* logf, float* SUMKV, float* SUMD) {
    LAS unsigned char* L = C.lds;
    constexpr int O_KRAW = 0, O_VRAW = 17408, O_KT = 34816, O_VT = 53248, O_SS = 71680, O_DEC = 73728;
    const int c = C.tid & 127, sg = C.tid >> 7, fr = C.lane & 15, fq = C.lane >> 4;
    for (int cq = C.vcu; cq < 256; cq += C.G) {
        const int unit0 = (cq >> 2) * 64 + (cq & 3) * 16;
        f32x4 acc[8];
#pragma unroll
        for (int tn = 0; tn < 8; ++tn) acc[tn] = (f32x4){0.f, 0.f, 0.f, 0.f};
        float bltot = 0.f;
        v4u rk[2], rv[2]; unsigned lf[16];
        { const EUnit u = e_unit(unit0); if (u.ret) tile_ld(rk, proj + (size_t)5 * M * 1024 + u.hoff, C.tid); tile_ld(rv, proj + (size_t)(u.ret ? 6 : 2) * M * 1024 + u.hoff, C.tid); if (!u.ret) lf_ld(lf, logf + u.hoff, c, sg); }
#pragma unroll 1
        for (int i = 0; i < 16; ++i) {
            const EUnit u = e_unit(unit0 + i);
            if (u.ret) tile_st(L + O_KRAW, rk, C.tid);
            tile_st(L + O_VRAW, rv, C.tid);
            float bc[16], blast, bmid; const float lg = log1pf(-exp2f(-5.f - (float)u.h));
#pragma unroll
            for (int q = 0; q < 16; ++q) bc[q] = u.ret ? lg : lf_cv(lf[q]);
            float kk[16];
#pragma unroll
            for (int q = 0; q < 16; ++q) kk[q] = u.ret ? 0.f : 1.f - __expf(bc[q]);
            if (i + 1 < 16) { const EUnit v = e_unit(unit0 + i + 1); if (v.ret) tile_ld(rk, proj + (size_t)5 * M * 1024 + v.hoff, C.tid); tile_ld(rv, proj + (size_t)(v.ret ? 6 : 2) * M * 1024 + v.hoff, C.tid); if (!v.ret) lf_ld(lf, logf + v.hoff, c, sg); }
            chunk_cumsum(bc, blast, bmid, (LAS float*)(L + O_SS), c, sg);
            unsigned kw[8], vw[8];
#pragma unroll
            for (int q = 0; q < 8; ++q) { const int t0 = 16 * sg + 2 * q;
                float k0 = kk[2 * q], k1 = kk[2 * q + 1];
                if (u.ret) { k0 = bf2f(*(const LAS unsigned short*)(L + O_KRAW + t0 * 272 + c * 2)); k1 = bf2f(*(const LAS unsigned short*)(L + O_KRAW + (t0 + 1) * 272 + c * 2)); }
                const unsigned short v0 = *(const LAS unsigned short*)(L + O_VRAW + t0 * 272 + c * 2), v1 = *(const LAS unsigned short*)(L + O_VRAW + (t0 + 1) * 272 + c * 2);
                kw[q] = pk2(k0 * __expf(fmaxf(blast - bc[2 * q], -80.f)), k1 * __expf(fmaxf(blast - bc[2 * q + 1], -80.f)));
                vw[q] = (unsigned)v0 | ((unsigned)v1 << 16); }
            *(LAS v4u*)(L + O_KT + c * 144 + sg * 32) = (v4u){kw[0], kw[1], kw[2], kw[3]}; *(LAS v4u*)(L + O_KT + c * 144 + sg * 32 + 16) = (v4u){kw[4], kw[5], kw[6], kw[7]};
            *(LAS v4u*)(L + O_VT + c * 144 + sg * 32) = (v4u){vw[0], vw[1], vw[2], vw[3]}; *(LAS v4u*)(L + O_VT + c * 144 + sg * 32 + 16) = (v4u){vw[4], vw[5], vw[6], vw[7]};
            if (sg == 0) ((LAS float*)(L + O_DEC))[c] = __expf(fmaxf(blast, -80.f));
            bltot += blast;
            LBAR();
            const f32x4 dec4 = *(const LAS f32x4*)(L + O_DEC + (16 * C.wave + 4 * fq) * 4);
#pragma unroll
            for (int tn = 0; tn < 8; ++tn) acc[tn] = acc[tn] * dec4;
#pragma unroll
            for (int ks = 0; ks < 2; ++ks) { const bf16x8 a = LFRAG(L + O_KT, 144, 16 * C.wave + fr, 32 * ks + 8 * fq);
#pragma unroll
                for (int tn = 0; tn < 8; ++tn) acc[tn] = __builtin_amdgcn_mfma_f32_16x16x32_bf16(a, LFRAG(L + O_VT, 144, 16 * tn + fr, 32 * ks + 8 * fq), acc[tn], 0, 0, 0); }
            LBAR();
        }
        float* kvp = SUMKV + (size_t)cq * 16384 + 16 * C.wave + 4 * fq;
#pragma unroll
        for (int tn = 0; tn < 8; ++tn) *(GAS f32x4*)(kvp + (16 * tn + fr) * 128) = acc[tn];
        if (sg == 0) SUMD[(size_t)cq * 128 + c] = __expf(fmaxf(bltot, -80.f));
    }
}
template <int VAR>
__device__ __forceinline__ void even_eb(const Ctx& C, const bf16* proj, const lf16* logf, const float* SUMKV, const float* SUMD, const float* nw_h, const float* nw_r, bf16* OB) {
    LAS unsigned char* L = C.lds;
    constexpr int O_Q = 0, O_K = 17408, O_QH = 34816, O_VRAW = 52224, O_VT = 69632, O_ST = 88064, O_SS = 122880, O_DEC = 124928, O_KT = 125440, O_P = O_VRAW, O_OB = 0;
    static_assert(O_KT + 128 * 144 <= CS_OFF + CS_BYTES, "lds map (EB)");
    const int c = C.tid & 127, sg = C.tid >> 7;
    for (int cq = C.vcu; cq < 256; cq += C.G) {
        const int chain = cq >> 2, qd = cq & 3, unit0 = chain * 64 + qd * 16;
        int fr = C.lane & 15, fq = C.lane >> 4;
        f32x4 S[8];
#pragma unroll
        for (int tn = 0; tn < 8; ++tn) S[tn] = (f32x4){0.f, 0.f, 0.f, 0.f};
        for (int qp = 0; qp < qd; ++qp) { const size_t cp = (size_t)(chain * 4 + qp);
            const f32x4 d4 = *(const GAS f32x4*)(SUMD + cp * 128 + 16 * C.wave + 4 * fq);
#pragma unroll
            for (int tn = 0; tn < 8; ++tn) S[tn] = S[tn] * d4 + *(const GAS f32x4*)(SUMKV + cp * 16384 + (16 * tn + fr) * 128 + 16 * C.wave + 4 * fq); }
#pragma unroll
        for (int tn = 0; tn < 8; ++tn) *(LAS v2u*)(L + O_ST + (16 * tn + fr) * 272 + (16 * C.wave + 4 * fq) * 2) = (v2u){pk2(S[tn][0], S[tn][1]), pk2(S[tn][2], S[tn][3])};
        f32x4 nwv[4];
        { const EUnit u0 = e_unit(unit0); const float* nw = (u0.ret ? nw_r : nw_h) + u0.h * 128 + (C.tid & 7) * 16;
#pragma unroll
          for (int q4 = 0; q4 < 4; ++q4) nwv[q4] = *(const GAS f32x4*)(nw + 4 * q4); }
        v4u rq[2][2], rk[2][2], rv[2][2], rg[2][2]; unsigned lf[2][16];
        auto pref = [&](v4u (&q_)[2], v4u (&k_)[2], v4u (&v_)[2], v4u (&g_)[2], unsigned (&lf_)[16], const int un) __attribute__((always_inline)) {
            const EUnit w_ = e_unit(un); tile_ld(q_, proj + (size_t)(w_.ret ? 4 : 0) * M * 1024 + w_.hoff, C.tid); if (w_.ret) tile_ld(k_, proj + (size_t)5 * M * 1024 + w_.hoff, C.tid);
            tile_ld(v_, proj + (size_t)(w_.ret ? 6 : 2) * M * 1024 + w_.hoff, C.tid);
            { const bf16* gp_ = proj + (size_t)(w_.ret ? 7 : 3) * M * 1024 + w_.hoff + (size_t)C.tid * 16; g_[0] = *(const GAS v4u*)gp_; g_[1] = *(const GAS v4u*)(gp_ + 8); }
            if (!w_.ret) lf_ld(lf_, logf + w_.hoff, c, sg); };
        pref(rq[0], rk[0], rv[0], rg[0], lf[0], unit0); pref(rq[1], rk[1], rv[1], rg[1], lf[1], unit0 + 1);
        auto chunk = [&](v4u (&q_)[2], v4u (&k_)[2], v4u (&v_)[2], v4u (&g_)[2], unsigned (&lf_)[16], const int i) __attribute__((always_inline)) {
            const int unit = unit0 + i;
            { int l_ = C.lane; asm volatile("" : "+v"(l_)); fr = l_ & 15; fq = l_ >> 4; }
            const EUnit u = e_unit(unit); const int ret = u.ret, h = u.h, hh = u.hh; const size_t m0 = u.m0;
            tile_st(L + O_Q, q_, C.tid); if (ret) tile_st(L + O_K, k_, C.tid);
            tile_st(L + O_VRAW, v_, C.tid);
            const v4u gp0 = g_[0], gp1 = g_[1];
            float bc[16], blast, bmid; const float lg = log1pf(-exp2f(-5.f - (float)h));
#pragma unroll
            for (int q = 0; q < 16; ++q) bc[q] = ret ? lg : lf_cv(lf_[q]);
            float kk[16];
#pragma unroll
            for (int q = 0; q < 16; ++q) kk[q] = ret ? 0.f : 1.f - __expf(bc[q]);
            if (i + 2 < 16 && !(VAR & 16)) pref(q_, k_, v_, g_, lf_, unit + 2);
            chunk_cumsum(bc, blast, bmid, (LAS float*)(L + O_SS), c, __builtin_amdgcn_readfirstlane(sg));
            unsigned vw[8], kw[8];
            int a0 = 16 * sg * 272 + c * 2; asm volatile("" : "+v"(a0));
            if (!(VAR & 1)) {
            constexpr float L2E = 1.44269504f, CL2 = 115.4f;
            const float bm2 = bmid * L2E;
            const f32x2 E12 = {__builtin_amdgcn_exp2f(fmaxf(bm2, -CL2)), __builtin_amdgcn_exp2f(fmaxf(blast * L2E - bm2, -CL2))};
#pragma unroll
            for (int q8 = 0; q8 < 8; ++q8) { f32x2 sq[2], sh[2];
#pragma unroll
                for (int z = 0; z < 2; ++z) {
                    const float e2 = __builtin_amdgcn_fmed3f(__builtin_fmaf(bc[2 * q8 + z], L2E, -bm2), -CL2, CL2);
                    const float ee = __builtin_amdgcn_exp2f(e2), ei = __builtin_amdgcn_rcpf(ee);
                    float kr_ = kk[2 * q8 + z]; if (ret) kr_ = bf2f(*(const LAS unsigned short*)(L + O_K + a0 + (2 * q8 + z) * 272));
                    const f32x2 qk = {bf2f(*(const LAS unsigned short*)(L + O_Q + a0 + (2 * q8 + z) * 272)), kr_};
                    sq[z] = qk * (f32x2){ee, ei}; sh[z] = sq[z] * E12; }
                const unsigned wq = pk2(sq[0].x, sq[1].x), wk = pk2(sq[0].y, sq[1].y), wh = pk2(sh[0].x, sh[1].x);
                kw[q8] = pk2(sh[0].y, sh[1].y);
                *(LAS unsigned short*)(L + O_Q + a0 + (2 * q8) * 272) = (unsigned short)wq; *(LAS unsigned short*)(L + O_Q + a0 + (2 * q8 + 1) * 272) = (unsigned short)(wq >> 16);
                *(LAS unsigned short*)(L + O_K + a0 + (2 * q8) * 272) = (unsigned short)wk; *(LAS unsigned short*)(L + O_K + a0 + (2 * q8 + 1) * 272) = (unsigned short)(wk >> 16);
                *(LAS unsigned short*)(L + O_QH + a0 + (2 * q8) * 272) = (unsigned short)wh; *(LAS unsigned short*)(L + O_QH + a0 + (2 * q8 + 1) * 272) = (unsigned short)(wh >> 16);
                const unsigned short v0 = *(const LAS unsigned short*)(L + O_VRAW + a0 + (2 * q8) * 272), v1 = *(const LAS unsigned short*)(L + O_VRAW + a0 + (2 * q8 + 1) * 272);
                vw[q8] = (unsigned)v0 | ((unsigned)v1 << 16); }
            *(LAS v4u*)(L + O_VT + c * 144 + sg * 32) = (v4u){vw[0], vw[1], vw[2], vw[3]}; *(LAS v4u*)(L + O_VT + c * 144 + sg * 32 + 16) = (v4u){vw[4], vw[5], vw[6], vw[7]};
            *(LAS v4u*)(L + O_KT + c * 144 + sg * 32) = (v4u){kw[0], kw[1], kw[2], kw[3]}; *(LAS v4u*)(L + O_KT + c * 144 + sg * 32 + 16) = (v4u){kw[4], kw[5], kw[6], kw[7]};
            if (sg == 0) ((LAS float*)(L + O_DEC))[c] = __expf(fmaxf(blast, -80.f));
            }
            LBAR();
            if (!(VAR & 2)) {
            const int tm = C.wave >> 1, t = 16 * tm + fr;
#pragma unroll
            for (int tt = 0; tt < 2; ++tt) { const int tn = 2 * (C.wave & 1) + tt; f32x4 acc = {0.f, 0.f, 0.f, 0.f};
                if (tn <= tm) {
#pragma unroll
                    for (int ks = 0; ks < 4; ++ks) acc = __builtin_amdgcn_mfma_f32_16x16x32_bf16(LFRAG(L + O_K, 272, 16 * tn + fr, 32 * ks + 8 * fq), LFRAG(L + O_Q, 272, t, 32 * ks + 8 * fq), acc, 0, 0, 0); }
                const int s0 = 16 * tn + 4 * fq;
#pragma unroll
                for (int r = 0; r < 4; ++r) if (s0 + r > t) acc[r] = 0.f;
                *(LAS v2u*)(L + O_P + t * 144 + s0 * 2) = (v2u){pk2(acc[0], acc[1]), pk2(acc[2], acc[3])}; }
            LBAR();
            f32x4 o[4]; const int tn0 = 4 * (C.wave & 1);
#pragma unroll
            for (int j = 0; j < 4; ++j) o[j] = (f32x4){0.f, 0.f, 0.f, 0.f};
#pragma unroll
            for (int ks = 0; ks < 2; ++ks) { const bf16x8 a = LFRAG(L + O_P, 144, t, 32 * ks + 8 * fq);
#pragma unroll
                for (int j = 0; j < 4; ++j) o[j] = __builtin_amdgcn_mfma_f32_16x16x32_bf16(LFRAG(L + O_VT, 144, 16 * (tn0 + j) + fr, 32 * ks + 8 * fq), a, o[j], 0, 0, 0); }
#pragma unroll
            for (int ks = 0; ks < 4; ++ks) { const bf16x8 a = LFRAG(L + O_QH, 272, t, 32 * ks + 8 * fq);
#pragma unroll
                for (int j = 0; j < 4; ++j) o[j] = __builtin_amdgcn_mfma_f32_16x16x32_bf16(LFRAG(L + O_ST, 272, 16 * (tn0 + j) + fr, 32 * ks + 8 * fq), a, o[j], 0, 0, 0); }
#pragma unroll
            for (int j = 0; j < 4; ++j) *(LAS f32x4*)(L + O_OB + t * 528 + (16 * (tn0 + j) + 4 * fq) * 4) = o[j];
            LBAR();
            } else { LBAR(); LBAR(); }
            if (!(VAR & 4))
            { const int row = C.tid >> 3, cg = C.tid & 7, ln_ = pg8::lane_now(); f32x2 x2[8];
#pragma unroll
              for (int q4 = 0; q4 < 4; ++q4) { const f32x4 v = *(const LAS f32x4*)(L + O_OB + row * 528 + cg * 64 + q4 * 16); x2[2 * q4] = (f32x2){v[0], v[1]}; x2[2 * q4 + 1] = (f32x2){v[2], v[3]}; }
              float mean = 0.f;
              if (ret) { f32x2 s2 = x2[0];
#pragma unroll
                  for (int e = 1; e < 8; ++e) s2 += x2[e];
                  float s = s2.x + s2.y; s += pg8::shfl_xor_l(s, 1, ln_); s += pg8::shfl_xor_l(s, 2, ln_); s += pg8::shfl_xor_l(s, 4, ln_); mean = s * (1.f / 128.f); }
              const f32x2 m2 = {mean, mean}; f32x2 ss2 = {0.f, 0.f};
#pragma unroll
              for (int e = 0; e < 8; ++e) { x2[e] -= m2; ss2 += x2[e] * x2[e]; }
              float ss = ss2.x + ss2.y; ss += pg8::shfl_xor_l(ss, 1, ln_); ss += pg8::shfl_xor_l(ss, 2, ln_); ss += pg8::shfl_xor_l(ss, 4, ln_);
              const float rstd = __builtin_amdgcn_rsqf(ss * (1.f / 128.f) + 1e-6f); const f32x2 r2 = {rstd, rstd};
              const unsigned gw[8] = {gp0.x, gp0.y, gp0.z, gp0.w, gp1.x, gp1.y, gp1.z, gp1.w};
              unsigned yw[8];
#pragma unroll
              for (int q4 = 0; q4 < 4; ++q4) { const f32x4 w = nwv[q4];
#pragma unroll
                  for (int e = 0; e < 2; ++e) { const f32x2 y = x2[2 * q4 + e] * r2 * (f32x2){w[2 * e], w[2 * e + 1]} * (f32x2){bflo(gw[2 * q4 + e]), bfhi(gw[2 * q4 + e])}; yw[2 * q4 + e] = pk2(y.x, y.y); } }
              bf16* op = OB + (m0 + row) * DM + hh * 128 + cg * 16;
              *(GAS v4u*)op = (v4u){yw[0], yw[1], yw[2], yw[3]}; *(GAS v4u*)(op + 8) = (v4u){yw[4], yw[5], yw[6], yw[7]}; }
            if (!(VAR & 8))
            { const f32x4 dec4 = *(const LAS f32x4*)(L + O_DEC + (16 * C.wave + 4 * fq) * 4);
#pragma unroll
              for (int tn = 0; tn < 8; ++tn) S[tn] = S[tn] * dec4;
#pragma unroll
              for (int ks = 0; ks < 2; ++ks) { const bf16x8 a = LFRAG(L + O_KT, 144, 16 * C.wave + fr, 32 * ks + 8 * fq);
#pragma unroll
                  for (int tn = 0; tn < 8; ++tn) S[tn] = __builtin_amdgcn_mfma_f32_16x16x32_bf16(a, LFRAG(L + O_VT, 144, 16 * tn + fr, 32 * ks + 8 * fq), S[tn], 0, 0, 0); }
#pragma unroll
              for (int tn = 0; tn < 8; ++tn) *(LAS v2u*)(L + O_ST + (16 * tn + fr) * 272 + (16 * C.wave + 4 * fq) * 2) = (v2u){pk2(S[tn][0], S[tn][1]), pk2(S[tn][2], S[tn][3])}; }
            LBAR();
        };
#pragma unroll 1
        for (int i = 0; i < 16; i += 2) { chunk(rq[0], rk[0], rv[0], rg[0], lf[0], i); chunk(rq[1], rk[1], rv[1], rg[1], lf[1], i + 1); }
    }
}
__device__ __forceinline__ void fox_cs(const float* lf, int bh, LAS float* cs, int tid, int lane, int wave) {
    { int t_ = threadIdx.x; asm volatile("" : "+v"(t_)); tid = t_; lane = t_ & 63; wave = __builtin_amdgcn_readfirstlane(t_ >> 6); }
    const int b = bh >> 4, h = bh & 15; const float* base = lf + ((size_t)b * SEQ + tid * 8) * 16 + h; float v[8];
#pragma unroll
    for (int e = 0; e < 8; ++e) v[e] = base[e * 16];
#pragma unroll
    for (int e = 1; e < 8; ++e) v[e] += v[e - 1];
    float x = v[7];
#pragma unroll
    for (int d = 1; d < 64; d <<= 1) { const float y = pg8::shfl_up_l(x, d, lane); if (lane >= d) x += y; }
    if (lane == 63) cs[4096 + wave] = x;
    __syncthreads();
    float off = x - v[7];
    for (int w = 0; w < wave; ++w) off += cs[4096 + w];
#pragma unroll
    for (int e = 0; e < 8; ++e) cs[tid * 8 + e] = (v[e] + off) * -11.313708498984761f;
    __syncthreads();
}
constexpr int CF_KB = 128;
constexpr int CF_IE = (DM / CF_KB) * (EVEN_IN / 32), CF_OO = (DM / CF_KB) * (DM / 32), CF_U = (DM / CF_KB) * (DFF2 / 32), CF_D = (DFF / CF_KB) * (DM / 32);
static_assert(DM % CF_KB == 0 && DFF % CF_KB == 0, "filler item height");
static_assert(CF_IE % 8 == 0 && CF_OO % 8 == 0 && CF_U % 8 == 0 && CF_D % 8 == 0, "eight wave items per claim never straddle two matrices");
__device__ __forceinline__ constexpr int cf_items(int set) { return set == 0 ? CF_IE + CF_U + CF_D : set == 1 ? CF_OO + CF_D : set == 2 ? CF_IE + CF_OO : set == 3 ? CF_IE + CF_OO : CF_U; }
__device__ __forceinline__ void conv_mat(int mat, int i, int r, const float* const* in, unsigned char* ws, LAS float* scr, int lane) {
    if (mat == 0) transpose_item<true, CF_KB>(in[4] + (size_t)i * DM * EVEN_IN, EVEN_IN, DM, EVEN_IN, in[1] + (2 * i) * DM, 1, (bf16*)(ws + WS_WIE) + (size_t)i * EVEN_IN * DM, scr, r, lane);
    else if (mat == 1) transpose_item<true, CF_KB>(in[8] + (size_t)i * DM * DM, DM, DM, DM, (const float*)nullptr, 0, (bf16*)(ws + WS_WOE) + (size_t)i * DM * DM, scr, r, lane);
    else if (mat == 2) transpose_item<true, CF_KB>(in[9] + (size_t)i * DM * ODD_IN, ODD_IN, DM, 8192, in[1] + (2 * i + 1) * DM, 0, (bf16*)(ws + WS_WIO) + (size_t)i * 8192 * DM, scr, r, lane);
    else if (mat == 3) transpose_item<true, CF_KB>(in[11] + (size_t)i * DM * DM, DM, DM, DM, (const float*)nullptr, 0, (bf16*)(ws + WS_WOO) + (size_t)i * DM * DM, scr, r, lane);
    else if (mat == 4) transpose_item<true, CF_KB>(in[12] + (size_t)i * DM * DFF2, DFF2, DM, DFF2, in[2] + i * DM, 2, (bf16*)(ws + WS_WU) + (size_t)i * DFF2 * DM, scr, r, lane);
    else transpose_item<true, CF_KB>(in[14] + (size_t)i * DFF * DM, DM, DFF, DM, (const float*)nullptr, 0, (bf16*)(ws + WS_WD) + (size_t)i * DM * DFF, scr, r, lane);
}
__device__ __forceinline__ void conv_item(int set, int r, const float* const* in, unsigned char* ws, LAS float* scr, int lane) {
    if (set == 0) {
        if (r < CF_IE) { conv_mat(2, 1, r, in, ws, scr, lane); return; } r -= CF_IE;
        if (r < CF_U) { conv_mat(4, 2, r, in, ws, scr, lane); return; } r -= CF_U;
        conv_mat(5, 2, r, in, ws, scr, lane);
    } else if (set == 1) {
        if (r < CF_OO) { conv_mat(3, 1, r, in, ws, scr, lane); return; } r -= CF_OO;
        conv_mat(5, 3, r, in, ws, scr, lane);
    } else if (set == 2) {
        if (r < CF_IE) { conv_mat(2, 0, r, in, ws, scr, lane); return; } r -= CF_IE;
        conv_mat(3, 0, r, in, ws, scr, lane);
    } else if (set == 3) {
        if (r < CF_IE) { conv_mat(0, 1, r, in, ws, scr, lane); return; } r -= CF_IE;
        conv_mat(1, 1, r, in, ws, scr, lane);
    } else conv_mat(4, 3, r, in, ws, scr, lane);
}
__device__ __forceinline__ void conv_filler(int set, const float* const* in, unsigned char* ws, unsigned* queue, LAS unsigned char* ldsb) {
    int t_ = threadIdx.x; asm volatile("" : "+v"(t_)); const int lane = t_ & 63, wave = __builtin_amdgcn_readfirstlane(t_ >> 6);
    const int nclaims = cf_items(set) / 8;
    volatile LAS int* qw = (volatile LAS int*)(ldsb + CS_OFF + 16384 + 32);
    LAS float* scr = (LAS float*)(ldsb + wave * 17408);
    __syncthreads();
    if (t_ == 0) qw[0] = (int)atomicAdd(queue, 1u);
    __syncthreads();
    int cl = qw[0];
    while (cl < nclaims) {
        unsigned nxt = 0u; if (t_ == 0) nxt = atomicAdd(queue, 1u);
        conv_item(set, cl * 8 + wave, in, ws, scr, lane);
        __syncthreads();
        if (t_ == 0) qw[0] = (int)nxt;
        __syncthreads();
        cl = qw[0];
    }
}
typedef fox::BlockRef<__hip_bfloat16, __hip_bfloat16> FoxRef;
__device__ __forceinline__ FoxRef fox_ref(const fox::SwaItem& it, int pass, const bf16* QH, const bf16* KH, const bf16* VH, bf16* OB) {
    const int qb = pass ? it.qb1 : it.qb0, b = it.bh >> 4, hh = it.bh & 15; FoxRef r; r.thr = 0.f;
    r.Q = (const __hip_bfloat16*)(QH + ((size_t)it.bh * SEQ + (size_t)qb * 256) * 128); r.K = (const __hip_bfloat16*)(KH + (size_t)it.bh * SEQ * 128); r.V = (const __hip_bfloat16*)(VH + (size_t)it.bh * SEQ * 128);
    const size_t oo = ((size_t)b * SEQ + (size_t)qb * 256) * DM + hh * 128; r.O = (__hip_bfloat16*)(OB + oo); r.P0 = qb * 256;
    return r;
}
__device__ __forceinline__ float fox_dmin(const bf16* Qb, const bf16* Kb, LAS float* red) {
    int t_ = threadIdx.x; asm volatile("" : "+v"(t_));
    const int row = t_ >> 1, hf = t_ & 1; const GAS v4u* qp = (const GAS v4u*)(Qb + (size_t)row * 128 + hf * 64); const GAS v4u* kp = (const GAS v4u*)(Kb + (size_t)row * 128 + hf * 64);
    v4u q8[8], k8[8];
#pragma unroll
    for (int i = 0; i < 8; ++i) { q8[i] = qp[i]; k8[i] = kp[i]; }
    float d = 0.f;
#pragma unroll
    for (int i = 0; i < 8; ++i) {
#pragma unroll
        for (int e = 0; e < 4; ++e) { d = __builtin_fmaf(bflo(q8[i][e]), bflo(k8[i][e]), d); d = __builtin_fmaf(bfhi(q8[i][e]), bfhi(k8[i][e]), d); } }
    const int ln_ = t_ & 63;
    d += pg8::shfl_xor_l(d, 1, ln_);
#pragma unroll
    for (int o = 2; o < 64; o <<= 1) d = fminf(d, pg8::shfl_xor_l(d, o, ln_));
    __syncthreads();
    if ((t_ & 63) == 0) red[t_ >> 6] = d;
    __syncthreads();
    float m = red[0];
#pragma unroll
    for (int w = 1; w < 8; ++w) m = fminf(m, red[w]);
    return m * 0.08838834764831845f;
}
__device__ __forceinline__ void fox_phase(const Ctx& C, char* lds, const bf16* QH, const bf16* KH, const bf16* VH, const bf16* G, bf16* OB, const float* LF, const unsigned* nrm, const float* bfv) {
    constexpr int nqb = SEQ / 256;
    LAS float* cs = (LAS float*)(C.lds + CS_OFF); const long gdelta = (const char*)G - (const char*)OB;
    int rank = 0;
    { const int my = C.lane & 15; const float bv = bfv[my];
      for (int o = 0; o < 16; ++o) { const float ov = bfv[o]; rank += (ov < bv || (ov == bv && o < my)) ? 1 : 0; } }
    for (int grp = C.vcu; grp < NBATCH * 64; grp += C.G) {
        const int b = grp >> 6, pr = (grp >> 3) & 7, x = grp & 7;
#pragma unroll 1
        for (int half = 0; half < 2; ++half) {
            const int want = half ? pr : 15 - pr;
            const int hh = __builtin_amdgcn_readfirstlane(__builtin_ctzll(__ballot(rank == want && C.lane < 16)));
            fox::SwaItem it; it.bh = b * 16 + hh; it.qb0 = x; it.qb1 = nqb - 1 - x;
            if (half) __syncthreads();
            fox_cs(LF, it.bh, cs, C.tid, C.lane, C.wave);
            float bqk;
            { const unsigned* nq = nrm + (size_t)it.bh * 4; const unsigned* nk = nrm + (size_t)(64 + it.bh) * 4;
              const float q2 = (__uint_as_float(nq[0]) + __uint_as_float(nq[1])) + (__uint_as_float(nq[2]) + __uint_as_float(nq[3])), k2 = (__uint_as_float(nk[0]) + __uint_as_float(nk[1])) + (__uint_as_float(nk[2]) + __uint_as_float(nk[3]));
              bqk = 1.02f * 0.08838834764831845f * sqrtf(q2 * k2); }
            FoxRef r0 = fox_ref(it, 0, QH, KH, VH, OB), r1 = fox_ref(it, 1, QH, KH, VH, OB);
            { const float d0 = fox_dmin((const bf16*)r0.Q, (const bf16*)r0.K + (size_t)r0.P0 * 128, cs + 4104), d1 = fox_dmin((const bf16*)r1.Q, (const bf16*)r1.K + (size_t)r1.P0 * 128, cs + 4104);
              r0.thr = (26.02f + bqk - fminf(d0, bqk)) * 11.313708498984761f; r1.thr = (26.02f + bqk - fminf(d1, bqk)) * 11.313708498984761f; }
            fox::Seam<__hip_bfloat16> S;
            fox::causal_swa_prime<__hip_bfloat16, __hip_bfloat16>(r0, SEQ, lds, S, cs);
            fox::causal_swa_block<__hip_bfloat16, __hip_bfloat16>(r0, r1, SEQ, SEQ, lds, S, cs, gdelta);
            fox::causal_swa_block<__hip_bfloat16, __hip_bfloat16>(r1, r1, SEQ, SEQ, lds, S, cs, gdelta);
        }
    }
}
constexpr int N_PHASES = 28;
struct Args { const float* in[15]; float* out; unsigned char* ws; int ph_lo, ph_hi; };
__global__ void __launch_bounds__(NWAVES * 64, 2) mk_fwd(Args args) {
    extern __shared__ __attribute__((aligned(16))) unsigned char lds[];
    { volatile LAS unsigned* MISC0 = (volatile LAS unsigned*)((LAS unsigned char*)lds + MISC_OFF); if (threadIdx.x < 112) MISC0[threadIdx.x] = 0u; }
    __syncthreads();
    XcdBarrier bar; bar.bar = (unsigned*)(args.ws + WS_CTL) + CW_BAR; bar.x = 0; bar.st = nullptr;
    if (MK_N_LAUNCHES == 1) bar = xcd_barrier_post((unsigned*)(args.ws + WS_CTL) + CW_BAR, (volatile LAS unsigned*)((LAS unsigned char*)lds + MISC_OFF) + 8);
    const int lo = args.ph_lo, hi = args.ph_hi; int ph = 0;
#ifndef PHSEL
#define PHSEL -1
#endif
#ifndef EBVAR
#define EBVAR 0
#endif
#ifndef REPN
#define REPN 1
#endif
#ifndef G1ALIGN
#define G1ALIGN true
#endif
#ifndef G1SP2
#define G1SP2 true
#endif
#ifndef REPMASK
#define REPMASK 0
#endif
#ifndef NULLEPI
#define NULLEPI 0
#endif
#define PH_BEGIN(k) if (lo <= ph && ph < hi) { for (int rep_ = 0; rep_ <= REPN * ((REPMASK >> (k)) & 1); ++rep_) { const bool dry_ = rep_ < REPN * ((REPMASK >> (k)) & 1); (void)dry_; Ctx C; { int t_ = threadIdx.x, b_ = blockIdx.x, g_ = gridDim.x; asm volatile("" : "+v"(t_), "+s"(b_), "+s"(g_)); C.lds = (LAS unsigned char*)lds; C.tid = t_; C.lane = t_ & 63; C.wave = __builtin_amdgcn_readfirstlane(t_ >> 6); \
        C.G = g_; C.vcu = (g_ % 8 == 0) ? (b_ % 8) * (g_ / 8) + b_ / 8 : b_; C.bx = b_; } \
    size_t z_ = 0; asm volatile("" : "+s"(z_)); unsigned char* ws = args.ws + z_; float* out = args.out + z_; const float* const* in = args.in;     \
    float* RS = (float*)(ws + WS_RSP); bf16* XB = (bf16*)(ws + WS_XB); bf16* OBF = (bf16*)(ws + WS_OB); bf16* PROJ = (bf16*)(ws + WS_PROJ); bf16* ACT = (bf16*)(ws + WS_ACT); \
    _Float16* LOGF = (_Float16*)(ws + WS_LOGF); bf16* KV = (bf16*)(ws + WS_KV); float* DEC = (float*)(ws + WS_DEC); bf16* ST = (bf16*)(ws + WS_ST); float* LF = (float*)(ws + WS_LF); \
    (void)RS; (void)XB; (void)OBF; (void)PROJ; (void)ACT; (void)LOGF; (void)KV; (void)DEC; (void)ST; (void)LF; (void)in; (void)out;
#define PH_END   if (dry_) { xcd_barrier(bar); } } if (ph + 1 < hi) { xcd_barrier(bar); } } ++ph;

    PH_BEGIN(0) if (PHSEL < 0 || PHSEL == 0) p0_prologue(C, in, ws, RS); PH_END

    for (int l = 0; l < DEPTH; ++l) {
        const int j = l >> 1;
        if ((l & 1) == 0) {
            PH_BEGIN(1) if (PHSEL < 0 || PHSEL == 1) {
                pg8::Gemm g{XB, (const bf16*)(ws + WS_WIE) + (size_t)j * EVEN_IN * DM, M, EVEN_IN, DM}; pg8::StaticOrder S; S.init(M, EVEN_IN, C.G, C.bx);
                pg8::Unit u0; S.next(0, u0); prep_rstd(C, RS, u0.pm, (LAS float*)(C.lds + CS_OFF + 8192));
                pg8::EpiEven E{PROJ, LOGF, pg8::RstdLds{(PG8_LAS float*)(C.lds + CS_OFF + 8192)}, in[5], j};
                if (NULLEPI == 1 && dry_) { pg8::EpiNull EN{(float*)(ws + WS_ST)}; pg8::gemm_phase<pg8::EpiNull, pg8::StaticOrder, true, true>(C.lds, g, S, EN); }
                else pg8::gemm_phase<pg8::EpiEven, pg8::StaticOrder, G1ALIGN, G1SP2>(C.lds, g, S, E); } PH_END
            PH_BEGIN(2) if (PHSEL < 0 || PHSEL == 2) even_ea(C, PROJ, LOGF, (float*)(ws + WS_KV), DEC); PH_END
            PH_BEGIN(4) if (PHSEL < 0 || PHSEL == 4) { if (dry_) even_eb<EBVAR>(C, PROJ, LOGF, (const float*)(ws + WS_KV), DEC, in[6] + j * DH, in[7] + j * DH, OBF); else even_eb<0>(C, PROJ, LOGF, (const float*)(ws + WS_KV), DEC, in[6] + j * DH, in[7] + j * DH, OBF); } PH_END
        } else {
            PH_BEGIN(5) if (PHSEL < 0 || PHSEL == 5) {
                pg8::Gemm g{XB, (const bf16*)(ws + WS_WIO) + (size_t)j * 8192 * DM, M, 8192, DM}; pg8::StaticOrder S; S.init(M, 8192, C.G, C.bx);
                pg8::Unit u0; S.next(0, u0); prep_rstd(C, RS, u0.pm, (LAS float*)(C.lds + CS_OFF + 8192));
                pg8::EpiOdd E{PROJ, PROJ + (size_t)3 * M * DM, pg8::RstdLds{(PG8_LAS float*)(C.lds + CS_OFF + 8192)}, (unsigned*)(ws + WS_CTL) + CW_NRM + (l >> 1) * 512, (PG8_LAS float*)(C.lds + CS_OFF)};
                if (NULLEPI == 1 && dry_) { pg8::EpiNull EN{(float*)(ws + WS_ST)}; pg8::gemm_phase<pg8::EpiNull, pg8::StaticOrder, true, true>(C.lds, g, S, EN); }
                else if (NULLEPI == 2 && dry_) { pg8::EpiProbe<1> EP{(bf16*)(ws + 940 * MiB), (bf16*)(ws + 940 * MiB) + (size_t)3 * M * DM, RS}; pg8::gemm_phase<pg8::EpiProbe<1>, pg8::StaticOrder, true, true>(C.lds, g, S, EP); }
                else if (NULLEPI == 3 && dry_) { pg8::EpiProbe<2> EP{(bf16*)(ws + 940 * MiB), (bf16*)(ws + 940 * MiB) + (size_t)3 * M * DM, RS}; pg8::gemm_phase<pg8::EpiProbe<2>, pg8::StaticOrder, true, true>(C.lds, g, S, EP); }
                else if (NULLEPI == 4 && dry_) { pg8::EpiProbe<3> EP{(bf16*)(ws + 940 * MiB), (bf16*)(ws + 940 * MiB) + (size_t)3 * M * DM, RS}; pg8::gemm_phase<pg8::EpiProbe<3>, pg8::StaticOrder, true, true>(C.lds, g, S, EP); }
                else pg8::gemm_phase<pg8::EpiOdd, pg8::StaticOrder, true, true>(C.lds, g, S, E);
                flogit_phase(C, XB, (const bf16*)(ws + WS_WF) + (size_t)j * 16 * DM, RS, in[10] + j * NFOX, LF); } PH_END
            PH_BEGIN(6) if (PHSEL < 0 || PHSEL == 6) { fox_phase(C, (char*)lds, PROJ, PROJ + (size_t)M * DM, PROJ + (size_t)2 * M * DM, PROJ + (size_t)3 * M * DM, OBF, LF, (const unsigned*)(ws + WS_CTL) + CW_NRM + (l >> 1) * 512, in[10] + j * NFOX);
                if (!dry_) conv_filler(l >> 1, in, ws, (unsigned*)(ws + WS_CTL) + CW_CONVQ + (l >> 1) * 64, C.lds); } PH_END
        }
        PH_BEGIN(7) if (PHSEL < 0 || PHSEL == 7) {
            const bf16* wo = (l & 1) ? (const bf16*)(ws + WS_WOO) + (size_t)j * DM * DM : (const bf16*)(ws + WS_WOE) + (size_t)j * DM * DM;
            pg8::Gemm g{OBF, wo, M, DM, DM}; pg8::StaticOrder S; S.init(M, DM, C.G, C.bx);
            pg8::EpiResid E{dry_ ? (bf16*)(ws + WS_ST) : XB, RS};
            if (NULLEPI == 1 && dry_) { pg8::EpiNull EN{(float*)(ws + WS_ST)}; pg8::gemm_phase<pg8::EpiNull, pg8::StaticOrder, true, true>(C.lds, g, S, EN); }
            else pg8::gemm_phase<pg8::EpiResid, pg8::StaticOrder, true, true>(C.lds, g, S, E); } PH_END
        PH_BEGIN(8) if (PHSEL < 0 || PHSEL == 8) {
            pg8::Gemm g{XB, (const bf16*)(ws + WS_WU) + (size_t)l * DFF2 * DM, M, DFF2, DM}; pg8::StaticOrder S; S.init(M, DFF2, C.G, C.bx);
            pg8::Unit u0; S.next(0, u0); prep_rstd(C, RS, u0.pm, (LAS float*)(C.lds + CS_OFF + 8192));
            pg8::EpiUpConv E{ACT, (float*)(ws + WS_SB), pg8::RstdLds{(PG8_LAS float*)(C.lds + CS_OFF + 8192)}, in[13] + (size_t)l * 3 * DFF2, (PG8_LAS float*)(C.lds + CS_OFF)};
            if (NULLEPI == 1 && dry_) { pg8::EpiNull EN{(float*)(ws + WS_ST)}; pg8::gemm_phase<pg8::EpiNull, pg8::StaticOrder, true, true>(C.lds, g, S, EN); }
            else pg8::gemm_phase<pg8::EpiUpConv, pg8::StaticOrder, true, true>(C.lds, g, S, E);
            if (!dry_ && l < 3) conv_filler(2 + l, in, ws, (unsigned*)(ws + WS_CTL) + CW_CONVQ + (2 + l) * 64, C.lds); } PH_END
        PH_BEGIN(9) if (PHSEL < 0 || PHSEL == 9) conv_fix(C, (const float*)(ws + WS_SB), in[13] + (size_t)l * 3 * DFF2, ACT); PH_END
        PH_BEGIN(10) if (PHSEL < 0 || PHSEL == 10) {
            pg8::Gemm g{ACT, (const bf16*)(ws + WS_WD) + (size_t)l * DM * DFF, M, DM, DFF}; pg8::StaticOrder S; S.init(M, DM, C.G, C.bx);
            pg8::EpiResid E{dry_ ? (bf16*)(ws + WS_ST) : XB, RS};
            if (NULLEPI == 1 && dry_) { pg8::EpiNull EN{(float*)(ws + WS_ST)}; pg8::gemm_phase<pg8::EpiNull, pg8::StaticOrder, true, true>(C.lds, g, S, EN); }
            else pg8::gemm_phase<pg8::EpiResid, pg8::StaticOrder, true, true>(C.lds, g, S, E); } PH_END
    }
    PH_BEGIN(11) if (PHSEL < 0 || PHSEL == 11) final_norm(C, XB, out, RS, in[3]); PH_END
#undef PH_BEGIN
#undef PH_END
}

extern "C" void kernel_launch(void* const* d_in, const int* in_sizes, int n_in, void* d_out, int out_size, void* d_ws, size_t ws_size, hipStream_t stream) {
    static int grid = 0;
    if (grid == 0) {
        if (n_in != 15 || in_sizes[0] != M * DM || out_size != M * DM || ws_size < WS_END) { fprintf(stderr, "kernel_launch: shape/workspace mismatch (n_in %d, in0 %d, out %d, ws %zu < %zu); nothing launched\n", n_in, n_in > 0 ? in_sizes[0] : -1, out_size, ws_size, (size_t)WS_END); grid = -1; return; }
        int dev = 0, cus = 0, per_cu = 0;
        if (hipGetDevice(&dev) != hipSuccess || hipDeviceGetAttribute(&cus, hipDeviceAttributeMultiprocessorCount, dev) != hipSuccess) { fprintf(stderr, "kernel_launch: device query failed\n"); grid = -1; return; }
        if (hipFuncSetAttribute((const void*)mk_fwd, hipFuncAttributeMaxDynamicSharedMemorySize, LDS_BYTES) != hipSuccess) { fprintf(stderr, "kernel_launch: hipFuncSetAttribute(%d B LDS) failed\n", LDS_BYTES); grid = -1; return; }
        if (hipOccupancyMaxActiveBlocksPerMultiprocessor(&per_cu, (const void*)mk_fwd, NWAVES * 64, LDS_BYTES) != hipSuccess || per_cu < 1) { fprintf(stderr, "kernel_launch: occupancy query reports %d workgroups per CU\n", per_cu); }
        (void)hipGetLastError();
        if (cus != 256) { fprintf(stderr, "kernel_launch: built for a 256-CU device (MI355X): the per-phase row-panel ownership of the GEMM phases assumes a 256-workgroup grid; this device has %d CUs; nothing launched\n", cus); grid = -1; return; }
        grid = cus;
    }
    if (grid < 0) return;
    if (hipMemsetAsync((char*)d_ws + WS_CTL, 0, CTL_ZERO_BYTES, stream) != hipSuccess) { fprintf(stderr, "kernel_launch: memset failed\n"); return; }
    Args a{};
    for (int i = 0; i < 15; ++i) a.in[i] = (const float*)d_in[i];
    a.out = (float*)d_out; a.ws = (unsigned char*)d_ws;
    if (MK_N_LAUNCHES == 1) { a.ph_lo = 0; a.ph_hi = N_PHASES; hipLaunchKernelGGL(mk_fwd, dim3(grid), dim3(NWAVES * 64), LDS_BYTES, stream, a); }
    else for (int p = 0; p < N_PHASES; ++p) { a.ph_lo = p; a.ph_hi = p + 1; hipLaunchKernelGGL(mk_fwd, dim3(grid), dim3(NWAVES * 64), LDS_BYTES, stream, a); }
    const hipError_t le = hipPeekAtLastError();
    if (le != hipSuccess) fprintf(stderr, "kernel_launch: launch failed: %s\n", hipGetErrorName(le));
}
```
